# Optimizing an MI355X kernel written in HIP

```python
import math
import jax
import jax.numpy as jnp
from jax import lax
import numpy as np

D_MODEL = 1024
BATCH = 8
SEQ = 2048
DEPTH = 4

N_MIXERS = 3
D_PLE = 256
NORM_EPS = 1e-6
Q_BLOCK = 128
NEG_INF = -1e30

MLA_HEADS = 16
MLA_Q_RANK = 384
MLA_KV_RANK = 256
MLA_NOPE = 64
MLA_ROPE = 32
MLA_V = 64
ROPE_THETA = 10000.0

DIL_PATTERNS = ((128, 1), (512, 4), (2048, 16))
DIL_GROUPS = len(DIL_PATTERNS)
DIL_HEADS = 16
DIL_HEAD_DIM = 64

REL_BUCKETS = 32
REL_MAX_DIST = 2048

FOX_HEADS = 16
FOX_HEAD_DIM = 64

D_FF = -(-8 * D_MODEL // (3 * 256)) * 256

kernel_name = 'hybrid_mla_dilated_fox_trunk'


def rms_norm(x, g):
    xf = x.astype(jnp.float32)
    y = xf * lax.rsqrt(jnp.mean(xf * xf, axis=-1, keepdims=True) + NORM_EPS)
    return (y * g.astype(jnp.float32)).astype(x.dtype)


def apply_rope(x, positions):
    half = x.shape[-1] // 2
    inv = ROPE_THETA ** (-jnp.arange(half, dtype=jnp.float32) / half)
    ang = positions.astype(jnp.float32)[:, :, None, None] * inv
    cos, sin = jnp.cos(ang), jnp.sin(ang)
    xf = x.astype(jnp.float32)
    x1, x2 = xf[..., :half], xf[..., half:]
    return jnp.concatenate([x1 * cos - x2 * sin, x2 * cos + x1 * sin], axis=-1).astype(x.dtype)


def causal_block_attention(q, k, v, scale, log_forget_cumsum=None):
    s_len = q.shape[1]
    outs = []
    for b0 in range(0, s_len, Q_BLOCK):
        b1 = b0 + Q_BLOCK
        qb, kb, vb = q[:, b0:b1], k[:, :b1], v[:, :b1]
        logits = jnp.einsum('bqhd,bkhd->bhqk', qb, kb).astype(jnp.float32) * scale
        if log_forget_cumsum is not None:
            c_q = jnp.transpose(log_forget_cumsum[:, b0:b1], (0, 2, 1))
            c_k = jnp.transpose(log_forget_cumsum[:, :b1], (0, 2, 1))
            logits = logits + (c_q[..., :, None] - c_k[..., None, :])
        q_idx = b0 + jnp.arange(Q_BLOCK)
        k_idx = jnp.arange(b1)
        causal = k_idx[None, :] <= q_idx[:, None]
        logits = jnp.where(causal, logits, NEG_INF)
        probs = jax.nn.softmax(logits, axis=-1).astype(v.dtype)
        outs.append(jnp.einsum('bhqk,bkhd->bqhd', probs, vb))
    return jnp.concatenate(outs, axis=1)


def t5_bucket(dist):
    max_exact = REL_BUCKETS // 2
    n = jnp.maximum(dist.astype(jnp.float32), 1.0)
    large = max_exact + (jnp.log(n / max_exact) / math.log(REL_MAX_DIST / max_exact)
                         * (REL_BUCKETS - max_exact)).astype(jnp.int32)
    large = jnp.minimum(large, REL_BUCKETS - 1)
    return jnp.where(dist < max_exact, dist, large)


def dilated_branch(q, k, v, dilation, span, bias_table):
    b, s_len, h, dh = q.shape
    sub_len = s_len // dilation
    n_blk = -(-sub_len // Q_BLOCK)
    pad_len = n_blk * Q_BLOCK

    def to_blocks(t):
        t = t.reshape(b, sub_len, dilation, h, dh).transpose(0, 2, 1, 3, 4)
        t = t.reshape(b * dilation, sub_len, h, dh)
        t = jnp.pad(t, ((0, 0), (0, pad_len - sub_len), (0, 0), (0, 0)))
        return t.reshape(b * dilation, n_blk, Q_BLOCK, h, dh)

    def with_previous(t):
        prev = jnp.concatenate([jnp.zeros_like(t[:, :1]), t[:, :-1]], axis=1)
        return jnp.concatenate([prev, t], axis=2)

    qs = to_blocks(q)
    kb = with_previous(to_blocks(k))
    vb = with_previous(to_blocks(v))

    logits = jnp.einsum('bnqhd,bnkhd->bnhqk', qs, kb).astype(jnp.float32) * (dh ** -0.5)
    i = jnp.arange(Q_BLOCK)
    j = jnp.arange(2 * Q_BLOCK)
    rel = Q_BLOCK + i[:, None] - j[None, :]
    bucket = t5_bucket(jnp.clip(rel, 0) * dilation)
    bias = jnp.transpose(bias_table[bucket].astype(jnp.float32), (2, 0, 1))
    key_pos = jnp.arange(n_blk)[:, None] * Q_BLOCK - Q_BLOCK + j[None, :]
    valid = ((rel >= 0) & (rel <= span))[None] & (key_pos >= 0)[:, None, :]
    logits = jnp.where(valid[None, :, None], logits + bias[None, None], NEG_INF)
    lse = jax.nn.logsumexp(logits, axis=-1, keepdims=True)
    probs = jnp.exp(logits - lse).astype(v.dtype)
    o = jnp.einsum('bnhqk,bnkhd->bnqhd', probs, vb)

    o = o.reshape(b * dilation, pad_len, h, dh)[:, :sub_len]
    o = o.reshape(b, dilation, sub_len, h, dh).transpose(0, 2, 1, 3, 4).reshape(b, s_len, h, dh)
    lse = jnp.transpose(lse[..., 0], (0, 1, 3, 2)).reshape(b * dilation, pad_len, h)[:, :sub_len]
    lse = lse.reshape(b, dilation, sub_len, h).transpose(0, 2, 1, 3).reshape(b, s_len, h)
    return o, lse


def mla_mixer(h, positions, w_a, q_norm, kv_norm, w_uq, w_ukv, w_o):
    b, s_len, _ = h.shape
    a = h @ w_a
    c_q = rms_norm(a[..., :MLA_Q_RANK], q_norm)
    c_kv = rms_norm(a[..., MLA_Q_RANK:MLA_Q_RANK + MLA_KV_RANK], kv_norm)
    k_rot = apply_rope(a[..., MLA_Q_RANK + MLA_KV_RANK:][:, :, None, :], positions)
    q = (c_q @ w_uq).reshape(b, s_len, MLA_HEADS, MLA_NOPE + MLA_ROPE)
    q = jnp.concatenate([q[..., :MLA_NOPE], apply_rope(q[..., MLA_NOPE:], positions)], axis=-1)
    kv = (c_kv @ w_ukv).reshape(b, s_len, MLA_HEADS, MLA_NOPE + MLA_V)
    k = jnp.concatenate([kv[..., :MLA_NOPE],
                         jnp.broadcast_to(k_rot, (b, s_len, MLA_HEADS, MLA_ROPE))], axis=-1)
    v = kv[..., MLA_NOPE:]
    o = causal_block_attention(q, k, v, (MLA_NOPE + MLA_ROPE) ** -0.5)
    return o.reshape(b, s_len, MLA_HEADS * MLA_V) @ w_o


def dilated_mixer(h, w_qkv, w_o, rel_bias):
    b, s_len, _ = h.shape
    qkv = (h @ w_qkv).reshape(b, s_len, DIL_GROUPS, 3, DIL_HEADS, DIL_HEAD_DIM)
    table = rel_bias.reshape(REL_BUCKETS, DIL_GROUPS, DIL_HEADS)
    outs, lses = [], []
    for g, (window, dilation) in enumerate(DIL_PATTERNS):
        o, lse = dilated_branch(qkv[:, :, g, 0], qkv[:, :, g, 1], qkv[:, :, g, 2],
                                dilation, window // dilation, table[:, g])
        outs.append(o)
        lses.append(lse)
    alpha = jax.nn.softmax(jnp.stack(lses, axis=0), axis=0)
    o = jnp.sum(alpha[..., None] * jnp.stack(outs, axis=0).astype(jnp.float32), axis=0).astype(h.dtype)
    return o.reshape(b, s_len, DIL_HEADS * DIL_HEAD_DIM) @ w_o


def fox_mixer(h, w_qkvf, b_f, w_o):
    b, s_len, _ = h.shape
    inner = FOX_HEADS * FOX_HEAD_DIM
    a = h @ w_qkvf
    qkv = a[..., :3 * inner].reshape(b, s_len, 3, FOX_HEADS, FOX_HEAD_DIM)
    log_f = jax.nn.log_sigmoid((a[..., 3 * inner:] + b_f).astype(jnp.float32))
    cum = jnp.cumsum(log_f, axis=1)
    o = causal_block_attention(qkv[:, :, 0], qkv[:, :, 1], qkv[:, :, 2], FOX_HEAD_DIM ** -0.5, cum)
    return o.reshape(b, s_len, inner) @ w_o


def swiglu(h, w_in, w_out):
    gu = h @ w_in
    return (jax.nn.silu(gu[..., :D_FF]) * gu[..., D_FF:]) @ w_out


def setup_inputs(seed: int = 0) -> dict:
    key = jax.random.key(seed)
    ks = jax.random.split(key, 20)
    f32 = jnp.float32
    n_a, n_b, n_c = (len(range(m, DEPTH, N_MIXERS)) for m in range(N_MIXERS))

    def dense(k, shape):
        return jax.random.normal(k, shape, f32) * shape[-2] ** -0.5

    def gain(k, shape):
        return 1.0 + 0.1 * jax.random.normal(k, shape, f32)

    x = jax.random.normal(ks[0], (BATCH, SEQ, D_MODEL), f32)
    p = jax.random.normal(ks[1], (DEPTH, BATCH, SEQ, D_PLE), f32)
    offsets = jax.random.randint(ks[2], (BATCH, 1), 0, 4096, jnp.int32)
    positions = (offsets + jnp.arange(SEQ, dtype=jnp.int32)[None, :]).astype(jnp.int32)
    norm_g = gain(ks[3], (DEPTH, 4, D_MODEL))
    ffn_w_in = dense(ks[4], (DEPTH, D_MODEL, 2 * D_FF))
    ffn_w_out = dense(ks[5], (DEPTH, D_FF, D_MODEL))
    ple_w_proj = dense(ks[6], (DEPTH, D_PLE, D_MODEL))
    ple_w_gate = dense(ks[7], (DEPTH, D_MODEL, D_MODEL))
    rel_bias = 0.5 * jax.random.normal(ks[8], (REL_BUCKETS, DIL_GROUPS * DIL_HEADS), f32)
    mla_w_a = dense(ks[9], (n_a, D_MODEL, MLA_Q_RANK + MLA_KV_RANK + MLA_ROPE))
    mla_q_norm = gain(ks[10], (n_a, MLA_Q_RANK))
    mla_kv_norm = gain(ks[11], (n_a, MLA_KV_RANK))
    mla_w_uq = dense(ks[12], (n_a, MLA_Q_RANK, MLA_HEADS * (MLA_NOPE + MLA_ROPE)))
    mla_w_ukv = dense(ks[13], (n_a, MLA_KV_RANK, MLA_HEADS * (MLA_NOPE + MLA_V)))
    mla_w_o = dense(ks[14], (n_a, MLA_HEADS * MLA_V, D_MODEL))
    dil_w_qkv = dense(ks[15], (n_b, D_MODEL, DIL_GROUPS * 3 * DIL_HEADS * DIL_HEAD_DIM))
    dil_w_o = dense(ks[16], (n_b, DIL_HEADS * DIL_HEAD_DIM, D_MODEL))
    fox_w_qkvf = dense(ks[17], (n_c, D_MODEL, 3 * FOX_HEADS * FOX_HEAD_DIM + FOX_HEADS))
    fox_b_f = jax.random.uniform(ks[18], (n_c, FOX_HEADS), f32, 1.0, 5.0)
    fox_w_o = dense(ks[19], (n_c, FOX_HEADS * FOX_HEAD_DIM, D_MODEL))
    return {'x': x, 'p': p, 'positions': positions, 'norm_g': norm_g,
            'ffn_w_in': ffn_w_in, 'ffn_w_out': ffn_w_out,
            'ple_w_proj': ple_w_proj, 'ple_w_gate': ple_w_gate, 'rel_bias': rel_bias,
            'mla_w_a': mla_w_a, 'mla_q_norm': mla_q_norm, 'mla_kv_norm': mla_kv_norm,
            'mla_w_uq': mla_w_uq, 'mla_w_ukv': mla_w_ukv, 'mla_w_o': mla_w_o,
            'dil_w_qkv': dil_w_qkv, 'dil_w_o': dil_w_o,
            'fox_w_qkvf': fox_w_qkvf, 'fox_b_f': fox_b_f, 'fox_w_o': fox_w_o}


def reference(x, p, positions, norm_g, ffn_w_in, ffn_w_out, ple_w_proj, ple_w_gate, rel_bias,
              mla_w_a, mla_q_norm, mla_kv_norm, mla_w_uq, mla_w_ukv, mla_w_o,
              dil_w_qkv, dil_w_o, fox_w_qkvf, fox_b_f, fox_w_o):
    h = x
    for i in range(DEPTH):
        mixer, j = i % N_MIXERS, i // N_MIXERS
        g = norm_g[i]
        hn = rms_norm(h, g[0])
        if mixer == 0:
            y = mla_mixer(hn, positions, mla_w_a[j], mla_q_norm[j], mla_kv_norm[j],
                          mla_w_uq[j], mla_w_ukv[j], mla_w_o[j])
        elif mixer == 1:
            y = dilated_mixer(hn, dil_w_qkv[j], dil_w_o[j], rel_bias)
        else:
            y = fox_mixer(hn, fox_w_qkvf[j], fox_b_f[j], fox_w_o[j])
        h = h + rms_norm(y, g[1])
        h = h + rms_norm(swiglu(rms_norm(h, g[2]), ffn_w_in[i], ffn_w_out[i]), g[3])
        h = h + (p[i] @ ple_w_proj[i]) * jax.nn.sigmoid(h @ ple_w_gate[i])
    return h
```

```cpp
#include <hip/hip_runtime.h>
#include <cstdio>
#include <cstdint>
#include <cmath>
namespace nv {
constexpr int S_ = 2048, DM_ = 1024, NB_ = 8, DFF_ = 2816;
constexpr float EPS_ = 1e-6f;

__device__ __forceinline__ float wsum(float v) {
#pragma unroll
    for (int o = 1; o < 64; o <<= 1) v += __shfl_xor(v, o);
    return v;
}
__global__ void rmsnorm(const float* in, int ldi, const float* g, float* out, int ldo, int rows, int D) {
    const int w = (blockIdx.x * blockDim.x + threadIdx.x) >> 6, lane = threadIdx.x & 63;
    if (w >= rows) return;
    const float* r = in + (size_t)w * ldi; float s = 0.f;
    for (int c = lane; c < D; c += 64) s += r[c] * r[c];
    s = wsum(s);
    const float rs = 1.0f / sqrtf(s / (float)D + EPS_);
    for (int c = lane; c < D; c += 64) out[(size_t)w * ldo + c] = r[c] * rs * g[c];
}
__global__ void resnorm(float* h, const float* y, const float* g, int rows, int D) {
    const int w = (blockIdx.x * blockDim.x + threadIdx.x) >> 6, lane = threadIdx.x & 63;
    if (w >= rows) return;
    const float* r = y + (size_t)w * D; float s = 0.f;
    for (int c = lane; c < D; c += 64) s += r[c] * r[c];
    s = wsum(s);
    const float rs = 1.0f / sqrtf(s / (float)D + EPS_);
    for (int c = lane; c < D; c += 64) h[(size_t)w * D + c] += r[c] * rs * g[c];
}
__global__ void __launch_bounds__(256) matmul(const float* A, int lda, const float* W, int N, float* C, int ldc, int K) {
    __shared__ float As[16][65], Ws[16][65];
    const int tid = threadIdx.x, tx = tid & 15, ty = tid >> 4, m0 = blockIdx.y * 64, n0 = blockIdx.x * 64;
    float acc[4][4];
#pragma unroll
    for (int i = 0; i < 4; ++i)
#pragma unroll
        for (int j = 0; j < 4; ++j) acc[i][j] = 0.f;
    for (int k0 = 0; k0 < K; k0 += 16) {
#pragma unroll
        for (int i = 0; i < 4; ++i) { const int e = tid + i * 256, r = e >> 4, kk = e & 15; As[kk][r] = A[(size_t)(m0 + r) * lda + k0 + kk]; }
#pragma unroll
        for (int i = 0; i < 4; ++i) { const int e = tid + i * 256, kk = e >> 6, c = e & 63; Ws[kk][c] = (n0 + c < N) ? W[(size_t)(k0 + kk) * N + n0 + c] : 0.f; }
        __syncthreads();
#pragma unroll
        for (int kk = 0; kk < 16; ++kk) {
            float a[4], b[4];
#pragma unroll
            for (int i = 0; i < 4; ++i) { a[i] = As[kk][ty * 4 + i]; b[i] = Ws[kk][tx * 4 + i]; }
#pragma unroll
            for (int i = 0; i < 4; ++i)
#pragma unroll
                for (int j = 0; j < 4; ++j) acc[i][j] = fmaf(a[i], b[j], acc[i][j]);
        }
        __syncthreads();
    }
#pragma unroll
    for (int i = 0; i < 4; ++i)
#pragma unroll
        for (int j = 0; j < 4; ++j) { const int c = n0 + tx * 4 + j; if (c < N) C[(size_t)(m0 + ty * 4 + i) * ldc + c] = acc[i][j]; }
}
__device__ __forceinline__ void rope_cs(int pos, int i, float& c, float& s) {
    const float inv = powf(10000.0f, -(float)i / 16.0f);
    const float ang = (float)pos * inv;
    const double ad = (double)ang, twopi = 6.283185307179586476925;
    const double k = rint(ad / twopi);
    const float r = (float)(ad - k * twopi);
    c = cosf(r); s = sinf(r);
}
__global__ void rope(float* x, int ld, int off, int stride, int nh, const int* pos) {
    const int idx = blockIdx.x * blockDim.x + threadIdx.x;
    if (idx >= S_ * nh * 16) return;
    const int i = idx & 15, hd = (idx >> 4) % nh, t = idx / (16 * nh);
    float c, s; rope_cs(pos[t], i, c, s);
    float* p = x + (size_t)t * ld + off + hd * stride;
    const float x1 = p[i], x2 = p[16 + i];
    p[i] = x1 * c - x2 * s; p[16 + i] = x2 * c + x1 * s;
}
__global__ void __launch_bounds__(256) attn(const float* Q, int ldq, int qs, const float* Kn, int ldk, int ks, const float* Kr, int ldkr, int dr,
                                             const float* V, int ldv, int vs, const float* cum, float scale, float* O) {
    const int t = blockIdx.x * 256 + threadIdx.x, h = blockIdx.y;
    const float* q = Q + (size_t)t * ldq + h * qs;
    float o[64];
#pragma unroll
    for (int d = 0; d < 64; ++d) o[d] = 0.f;
    float m = -3.0e38f, l = 0.f;
    const float ct = cum ? cum[t * 16 + h] : 0.f;
    for (int s = 0; s <= t; ++s) {
        const float* k = Kn + (size_t)s * ldk + h * ks; float dot = 0.f;
#pragma unroll 8
        for (int d = 0; d < 64; ++d) dot = fmaf(q[d], k[d], dot);
        if (dr) { const float* kr = Kr + (size_t)s * ldkr;
#pragma unroll 8
            for (int d = 0; d < 32; ++d) dot = fmaf(q[64 + d], kr[d], dot); }
        float sc = dot * scale; if (cum) sc += ct - cum[s * 16 + h];
        const float mn = fmaxf(m, sc), al = expf(m - mn), p = expf(sc - mn);
        l = l * al + p; m = mn;
        const float* v = V + (size_t)s * ldv + h * vs;
#pragma unroll
        for (int d = 0; d < 64; ++d) o[d] = o[d] * al + p * v[d];
    }
    const float il = 1.0f / l;
#pragma unroll
    for (int d = 0; d < 64; ++d) O[(size_t)t * 1024 + h * 64 + d] = o[d] * il;
}
__device__ __forceinline__ int t5_bucket(int dist) {
    if (dist < 16) return dist;
    const float n = (float)dist;
    int large = 16 + (int)(logf(n / 16.0f) / 4.852030263919617f * 16.0f);
    return large < 31 ? large : 31;
}
__global__ void __launch_bounds__(256) dil_attn(const float* qkv, const float* rel_bias, float* O) {
    const int t = blockIdx.x * 256 + threadIdx.x, h = blockIdx.y;
    float Oa[64];
#pragma unroll
    for (int d = 0; d < 64; ++d) Oa[d] = 0.f;
    float Mx = -3.0e38f, Wt = 0.f;
    for (int g = 0; g < 3; ++g) {
        const int dil = (g == 0) ? 1 : (g == 1) ? 4 : 16;
        const float* q = qkv + (size_t)t * 9216 + g * 3072 + h * 64;
        float o[64];
#pragma unroll
        for (int d = 0; d < 64; ++d) o[d] = 0.f;
        float m = -3.0e38f, l = 0.f;
        for (int j = 0; j <= 128; ++j) {
            const int s = t - j * dil; if (s < 0) break;
            const float* k = qkv + (size_t)s * 9216 + g * 3072 + 1024 + h * 64; float dot = 0.f;
#pragma unroll 8
            for (int d = 0; d < 64; ++d) dot = fmaf(q[d], k[d], dot);
            const float sc = dot * 0.125f + rel_bias[t5_bucket(j * dil) * 48 + g * 16 + h];
            const float mn = fmaxf(m, sc), al = expf(m - mn), p = expf(sc - mn);
            l = l * al + p; m = mn;
            const float* v = k + 1024;
#pragma unroll
            for (int d = 0; d < 64; ++d) o[d] = o[d] * al + p * v[d];
        }
        const float lse = m + logf(l), il = 1.0f / l;
        const float Mn = fmaxf(Mx, lse), a0 = expf(Mx - Mn), a1 = expf(lse - Mn);
        Wt = Wt * a0 + a1; Mx = Mn;
#pragma unroll
        for (int d = 0; d < 64; ++d) Oa[d] = Oa[d] * a0 + a1 * (o[d] * il);
    }
    const float iw = 1.0f / Wt;
#pragma unroll
    for (int d = 0; d < 64; ++d) O[(size_t)t * 1024 + h * 64 + d] = Oa[d] * iw;
}
__global__ void fox_cum(const float* a, const float* bf, float* cum) {
    const int h = threadIdx.x; if (h >= 16) return;
    float c = 0.f;
    for (int t = 0; t < S_; ++t) { const float z = a[(size_t)t * 3088 + 3072 + h] + bf[h];
        const float ls = fminf(z, 0.f) - log1pf(expf(-fabsf(z))); c += ls; cum[t * 16 + h] = c; }
}
__global__ void swiglu(const float* gu, float* act) {
    const int idx = blockIdx.x * blockDim.x + threadIdx.x; if (idx >= S_ * DFF_) return;
    const int r = idx / DFF_, c = idx % DFF_;
    const float g = gu[(size_t)r * 2 * DFF_ + c], u = gu[(size_t)r * 2 * DFF_ + DFF_ + c];
    act[idx] = g / (1.0f + expf(-g)) * u;
}
__global__ void ple_add(float* h, const float* pp, const float* gt) {
    const int idx = blockIdx.x * blockDim.x + threadIdx.x; if (idx >= S_ * DM_) return;
    h[idx] += pp[idx] / (1.0f + expf(-gt[idx]));
}
__global__ void copyf(const float* a, float* b, int n) { const int i = blockIdx.x * blockDim.x + threadIdx.x; if (i < n) b[i] = a[i]; }

struct In { const float *x, *p; const int* pos; const float *norm_g, *ffn_in, *ffn_out, *ple_proj, *ple_gate, *rel_bias, *mla_a, *mla_qn, *mla_kvn, *mla_uq, *mla_ukv, *mla_o, *dil_qkv, *dil_o, *fox_qkvf, *fox_bf, *fox_o; };

static inline void mm(hipStream_t st, const float* A, int lda, const float* W, int N, float* C, int ldc, int K, int M) {
    hipLaunchKernelGGL(matmul, dim3((N + 63) / 64, M / 64), dim3(256), 0, st, A, lda, W, N, C, ldc, K);
}
static void run_batch(hipStream_t st, const In& I, int b, float* h, float* scr, int l0, int l1) {
    float* hn = scr; float* t1 = hn + (size_t)S_ * 1024; float* t2 = t1 + (size_t)S_ * 9216; float* t3 = t2 + (size_t)S_ * 2048;
    float* o = t3 + (size_t)S_ * 2048; float* y = o + (size_t)S_ * 1024; float* cum = y + (size_t)S_ * 1024;
    const int* pos = I.pos + b * S_;
    const int rb = S_ * 64 / 256;
    for (int i = l0; i < l1; ++i) {
        const int mixer = i % 3, j = i / 3; const float* g = I.norm_g + (size_t)i * 4 * 1024;
        hipLaunchKernelGGL(rmsnorm, dim3(rb), dim3(256), 0, st, h, 1024, g, hn, 1024, S_, 1024);
        if (mixer == 0) {
            float* a = t1;
            mm(st, hn, 1024, I.mla_a + (size_t)j * 1024 * 672, 672, a, 672, 1024, S_);
            float* cq = t2; float* ckv = t2 + (size_t)S_ * 384;
            hipLaunchKernelGGL(rmsnorm, dim3(rb), dim3(256), 0, st, a, 672, I.mla_qn + j * 384, cq, 384, S_, 384);
            hipLaunchKernelGGL(rmsnorm, dim3(rb), dim3(256), 0, st, a + 384, 672, I.mla_kvn + j * 256, ckv, 256, S_, 256);
            hipLaunchKernelGGL(rope, dim3((S_ * 16 + 255) / 256), dim3(256), 0, st, a, 672, 640, 0, 1, pos);
            float* q = t3; float* kv = t1 + (size_t)S_ * 672;
            mm(st, cq, 384, I.mla_uq + (size_t)j * 384 * 1536, 1536, q, 1536, 384, S_);
            mm(st, ckv, 256, I.mla_ukv + (size_t)j * 256 * 2048, 2048, kv, 2048, 256, S_);
            hipLaunchKernelGGL(rope, dim3((S_ * 16 * 16 + 255) / 256), dim3(256), 0, st, q, 1536, 64, 96, 16, pos);
            hipLaunchKernelGGL(attn, dim3(S_ / 256, 16), dim3(256), 0, st, q, 1536, 96, kv, 2048, 128, a + 640, 672, 32, kv + 64, 2048, 128, (const float*)nullptr, 1.0f / sqrtf(96.0f), o);
            mm(st, o, 1024, I.mla_o + (size_t)j * 1024 * 1024, 1024, y, 1024, 1024, S_);
        } else if (mixer == 1) {
            float* qkv = t1;
            mm(st, hn, 1024, I.dil_qkv + (size_t)j * 1024 * 9216, 9216, qkv, 9216, 1024, S_);
            hipLaunchKernelGGL(dil_attn, dim3(S_ / 256, 16), dim3(256), 0, st, qkv, I.rel_bias, o);
            mm(st, o, 1024, I.dil_o + (size_t)j * 1024 * 1024, 1024, y, 1024, 1024, S_);
        } else {
            float* a = t1;
            mm(st, hn, 1024, I.fox_qkvf + (size_t)j * 1024 * 3088, 3088, a, 3088, 1024, S_);
            hipLaunchKernelGGL(fox_cum, dim3(1), dim3(64), 0, st, a, I.fox_bf + j * 16, cum);
            hipLaunchKernelGGL(attn, dim3(S_ / 256, 16), dim3(256), 0, st, a, 3088, 64, a + 1024, 3088, 64, (const float*)nullptr, 0, 0, a + 2048, 3088, 64, cum, 0.125f, o);
            mm(st, o, 1024, I.fox_o + (size_t)j * 1024 * 1024, 1024, y, 1024, 1024, S_);
        }
        hipLaunchKernelGGL(resnorm, dim3(rb), dim3(256), 0, st, h, y, g + 1024, S_, 1024);
        hipLaunchKernelGGL(rmsnorm, dim3(rb), dim3(256), 0, st, h, 1024, g + 2048, hn, 1024, S_, 1024);
        float* gu = t1; float* act = t1 + (size_t)S_ * 5632;
        mm(st, hn, 1024, I.ffn_in + (size_t)i * 1024 * 5632, 5632, gu, 5632, 1024, S_);
        hipLaunchKernelGGL(swiglu, dim3((S_ * DFF_ + 255) / 256), dim3(256), 0, st, gu, act);
        mm(st, act, 2816, I.ffn_out + (size_t)i * 2816 * 1024, 1024, y, 1024, 2816, S_);
        hipLaunchKernelGGL(resnorm, dim3(rb), dim3(256), 0, st, h, y, g + 3072, S_, 1024);
        float* pp = t2; float* gt = t3;
        mm(st, I.p + ((size_t)i * NB_ + b) * S_ * 256, 256, I.ple_proj + (size_t)i * 256 * 1024, 1024, pp, 1024, 256, S_);
        mm(st, h, 1024, I.ple_gate + (size_t)i * 1024 * 1024, 1024, gt, 1024, 1024, S_);
        hipLaunchKernelGGL(ple_add, dim3((S_ * DM_ + 255) / 256), dim3(256), 0, st, h, pp, gt);
    }
}
}
extern "C" void kernel_launch(void* const* d_in, const int* in_sizes, int n_in, void* d_out, int out_size, void* d_ws, size_t ws_size, hipStream_t stream) {
    nv::In I;
    I.x = (const float*)d_in[0]; I.p = (const float*)d_in[1]; I.pos = (const int*)d_in[2]; I.norm_g = (const float*)d_in[3];
    I.ffn_in = (const float*)d_in[4]; I.ffn_out = (const float*)d_in[5]; I.ple_proj = (const float*)d_in[6]; I.ple_gate = (const float*)d_in[7];
    I.rel_bias = (const float*)d_in[8]; I.mla_a = (const float*)d_in[9]; I.mla_qn = (const float*)d_in[10]; I.mla_kvn = (const float*)d_in[11];
    I.mla_uq = (const float*)d_in[12]; I.mla_ukv = (const float*)d_in[13]; I.mla_o = (const float*)d_in[14]; I.dil_qkv = (const float*)d_in[15];
    I.dil_o = (const float*)d_in[16]; I.fox_qkvf = (const float*)d_in[17]; I.fox_bf = (const float*)d_in[18]; I.fox_o = (const float*)d_in[19];
    float* out = (float*)d_out; float* scr = (float*)d_ws;
    for (int b = 0; b < 8; ++b) {
        float* h = out + (size_t)b * 2048 * 1024;
        hipMemcpyAsync(h, I.x + (size_t)b * 2048 * 1024, (size_t)2048 * 1024 * 4, hipMemcpyDeviceToDevice, stream);
        nv::run_batch(stream, I, b, h, scr, 0, 4);
    }
}
```

```cpp
#include <hip/hip_runtime.h>
#include <hip/hip_cooperative_groups.h>
#include <cstdio>
#include <cstdint>
#include <cmath>
#define MK_MODE 0
#define LAS __attribute__((address_space(3)))
#define GAS __attribute__((address_space(1)))
typedef unsigned short bf16_t;
typedef short bf16x8 __attribute__((ext_vector_type(8)));
typedef short s16x4 __attribute__((ext_vector_type(4)));
typedef float f32x2 __attribute__((ext_vector_type(2)));
typedef float f32x4 __attribute__((ext_vector_type(4)));
typedef float f32x16 __attribute__((ext_vector_type(16)));
typedef unsigned u32x2 __attribute__((ext_vector_type(2)));
typedef unsigned u32x4 __attribute__((ext_vector_type(4)));
typedef __bf16 bf16x2_t __attribute__((ext_vector_type(2)));

constexpr int MTOK = 16384, DMODEL = 1024, SEQL = 2048, NBATCH = 8, DFF = 2816;
constexpr float NEPS = 1e-6f;
constexpr float LOG2E = 1.4426950408889634f;
constexpr float C2_64 = 0.125f * LOG2E;
constexpr float C2_96 = 0.10206207261596575f * LOG2E;

__device__ __forceinline__ unsigned cvtpk(float lo, float hi) { f32x2 v = {lo, hi}; bf16x2_t b = __builtin_convertvector(v, bf16x2_t); return __builtin_bit_cast(unsigned, b); }
__device__ __forceinline__ float bf_lo(unsigned u) { return __uint_as_float(u << 16); }
__device__ __forceinline__ float bf_hi(unsigned u) { return __uint_as_float(u & 0xffff0000u); }
__device__ __forceinline__ float wave_sum(float v) {
#pragma unroll
    for (int o = 1; o < 64; o <<= 1) v += __shfl_xor(v, o);
    return v;
}
typedef unsigned long long u64;
constexpr float SS_SCALE = 16777216.0f, SS_INV = 1.0f / 16777216.0f;
__device__ __forceinline__ void ss_add(u64* p, float s) { atomicAdd(p, (u64)(s * SS_SCALE + 0.5f)); }
__device__ __forceinline__ float ss_get(const u64* p) { return (float)(*p) * SS_INV; }
__device__ __forceinline__ float sigmoidf_(float x) { return 1.0f / (1.0f + __expf(-x)); }

constexpr size_t MiB = 1u << 20;
constexpr size_t WS_CTL = 0;
constexpr size_t WS_SS = 1 * MiB;
constexpr size_t WS_ROPE = 3 * MiB;
constexpr size_t WS_BIAS = 5 * MiB;
constexpr size_t WS_LF = 6 * MiB;
constexpr size_t WS_LSE = 7 * MiB;
constexpr size_t WS_KR = 26 * MiB;
constexpr size_t WS_WMIX = 8 * MiB;
constexpr size_t WS_WO = 27 * MiB;
constexpr size_t WS_WIN = 30 * MiB;
constexpr size_t WS_WOUT = 41 * MiB;
constexpr size_t WS_WPROJ = 47 * MiB;
constexpr size_t WS_WGATE = 48 * MiB;
constexpr size_t WS_XN0 = 50 * MiB;
constexpr size_t WS_XN1 = 82 * MiB;
constexpr size_t WS_BIG = 114 * MiB;
constexpr size_t BIG_ARAW = 0, BIG_Q = 24 * MiB, BIG_KN = 72 * MiB, BIG_V = 104 * MiB;
constexpr size_t BIG_FQ = 0, BIG_FK = 32 * MiB, BIG_FV = 64 * MiB;
constexpr size_t BIG_QKVG = 0;
constexpr size_t BIG_O = 136 * MiB, BIG_Y = 24 * MiB;
constexpr size_t BIG_ACT = 0, BIG_Y2 = 96 * MiB, BIG_PP = 128 * MiB, BIG_PBF = 0;
constexpr size_t WS_END = WS_BIG + 168 * MiB;
constexpr int SS_IN = 0  , SS_Y1 = 4  , SS_Y2 = 8  , SS_Q = 12  , SS_KV = 14  ;

constexpr int RING_BYTES = 131072;
constexpr int LDS_BYTES = 147456;

struct Args { const float* in[20]; float* out; unsigned char* ws; int ph_lo, ph_hi; };

__device__ __forceinline__ int wrow_map(int n, int mode) {
    if (mode == 0) return n;
    const int up = n >= DFF, c = up ? n - DFF : n;
    return 32 * (c >> 4) + (up ? 16 : 0) + (c & 15);
}
__device__ __forceinline__ void cvt_item(const float* W, int K, int N, bf16_t* WT, const float* gv, int mode, LAS float* scr, int item, int lane) {
    const int nblk = (N + 31) / 32, kb = item / nblk, nb = item % nblk, k0 = 64 * kb, n0 = 32 * nb;
    const int nn = lane & 31; const bool nok = (n0 + nn) < N;
#pragma unroll 8
    for (int i = 0; i < 32; ++i) { const int kk = 2 * i + (lane >> 5);
        float v = nok ? W[(size_t)(k0 + kk) * N + n0 + nn] : 0.f; if (gv) v *= gv[k0 + kk];
        scr[kk * 33 + nn] = v; }
    asm volatile("s_waitcnt lgkmcnt(0)" ::: "memory");
    const int c = lane & 7;
#pragma unroll
    for (int j = 0; j < 4; ++j) { const int n = (lane >> 3) + 8 * j; const LAS float* s = scr + (8 * c) * 33 + n;
        u32x4 o; o.x = cvtpk(s[0 * 33], s[1 * 33]); o.y = cvtpk(s[2 * 33], s[3 * 33]); o.z = cvtpk(s[4 * 33], s[5 * 33]); o.w = cvtpk(s[6 * 33], s[7 * 33]);
        if (n0 + n < N) *(u32x4*)(WT + (size_t)wrow_map(n0 + n, mode) * K + k0 + 8 * c) = o; }
    asm volatile("s_waitcnt lgkmcnt(0)" ::: "memory");
}
struct CvtJob { const float* W; bf16_t* WT; const float* gv; int K, N, Npad, mode; };
__device__ __forceinline__ void cvt_run(const CvtJob& J, LAS float* scr, int gw, int ngw, int lane) {
    if (J.W == nullptr) return;
    const int nitems = (J.K / 64) * ((J.N + 31) / 32);
    for (int it = gw; it < nitems; it += ngw) cvt_item(J.W, J.K, J.N, J.WT, J.gv, J.mode, scr, it, lane);
    const int padrows = J.Npad - J.N; const int chunks = padrows * (J.K / 8);
    for (int c = gw * 64 + lane; c < chunks; c += ngw * 64) { const int r = c / (J.K / 8), cc = c % (J.K / 8);
        *(u32x4*)(J.WT + (size_t)(J.N + r) * J.K + cc * 8) = (u32x4){0u, 0u, 0u, 0u}; }
}
namespace pg8 {
constexpr int BM = 256, BK = 64, HALF = 128, HTB = HALF * BK * 2, STAGE_BYTES = 8 * HTB, NXCD = 8, WGM = 8;
__device__ __forceinline__ int lds_byte(int r, int c) { const int st = (r >> 4) * 2 + (c >> 5), rr = r & 15, cc = c & 31, ob = rr * 64 + cc * 2; return st * 1024 + (ob ^ (((ob >> 9) & 1) << 5)); }
__device__ __forceinline__ void stage_rc(int b, int& R, int& C) { const int st = b / 1024, sb = b % 1024, swz = sb ^ (((sb >> 9) & 1) << 5); R = (st >> 1) * 16 + swz / 64; C = (st & 1) * 32 + (swz % 64) / 2; }
__device__ __forceinline__ int perm32(int rho) { const int n = rho >> 4, i = rho & 15; return 8 * (i >> 2) + 4 * n + (i & 3); }

struct Unit { int pm, pn; };
struct Gemm { const bf16_t* A; const bf16_t* Bt; int lda, ldb, M, N, K; };

struct StaticOrder {
    int nM, nN, nwg, G, c;
    __device__ void init(int M, int N, int G_, int c_) { nM = M / BM; nN = N / BM; nwg = nM * nN; G = G_; c = c_; }
    __device__ bool next(int i, Unit& u) const {
        const long L = (long)i * G + c; if (L >= nwg) return false;
        int wgid = (int)L; { const int q = nwg / NXCD, r = nwg % NXCD, xcd = wgid % NXCD, off = wgid / NXCD; wgid = (xcd < r ? xcd * (q + 1) : r * (q + 1) + (xcd - r) * q) + off; }
        const int nig = WGM * nN, gid = wgid / nig, fm = gid * WGM, gsz = (nM - fm) < WGM ? (nM - fm) : WGM;
        u.pm = fm + ((wgid % nig) % gsz); u.pn = (wgid % nig) / gsz; return true;
    }
};

typedef f32x4 Acc[2][2][4][2];

template <class Epi, bool ALIGN_EPI, bool SP2>
__device__ __forceinline__ void gemm_phase(LAS unsigned char* lds, const Gemm g, const StaticOrder& S, const Epi& E, const int tid) {
    const int wid = __builtin_amdgcn_readfirstlane(tid >> 6), lane = tid & 63, wr = wid >> 2, wc = wid & 3, fr = lane & 15, fq = lane >> 4;
    int K = g.K; asm volatile("" : "+s"(K)); const int nt = K / BK;
    unsigned voffA[2], voffB[2];
#pragma unroll
    for (int i = 0; i < 2; ++i) { int R, C; stage_rc(tid * 16 + i * 8192, R, C); const int Rb = Epi::PERM ? ((R & ~31) + perm32(R & 31)) : R;
        voffA[i] = (unsigned)(R * g.lda + C) * 2u; voffB[i] = (unsigned)(Rb * g.ldb + C) * 2u; }
    const size_t kstep = (size_t)(BK * 2);
    const size_t hstepA = (size_t)HALF * g.lda * 2, hstepB = (size_t)HALF * g.ldb * 2;
    const size_t tstepA = 2 * hstepA, tstepB = 2 * hstepB;
    const unsigned ldsw = (unsigned)wid * 1024u;
    const int aoff = lds_byte(wr * 64 + fr, fq * 8), boff = lds_byte(wc * 32 + fr, fq * 8);
#define PG8_SA(b, h) (((b) * 2 + (h)) * HTB)
#define PG8_SB(b, h) ((4 + (b) * 2 + (h)) * HTB)
#define PG8_STAGE(bufoff, gbase, voff) do { _Pragma("unroll") for (int _i = 0; _i < 2; ++_i) \
        __builtin_amdgcn_global_load_lds((const unsigned*)((const char*)(gbase) + (voff)[_i]), (LAS unsigned*)(lds + (bufoff) + ldsw + _i * 8192), 16, 0, 0); } while (0)
#define PG8_LDA(dst, b, h) do { _Pragma("unroll") for (int m = 0; m < 4; ++m) _Pragma("unroll") for (int k = 0; k < 2; ++k) dst[m][k] = *(const LAS bf16x8*)(lds + PG8_SA(b, h) + aoff + m * 2048 + k * 1024); } while (0)
#define PG8_LDB(dst, b, h) do { _Pragma("unroll") for (int n = 0; n < 2; ++n) _Pragma("unroll") for (int k = 0; k < 2; ++k) dst[n][k] = *(const LAS bf16x8*)(lds + PG8_SB(b, h) + boff + n * 2048 + k * 1024); } while (0)
#define PG8_MMA(ai, bj, At, Bt) do { __builtin_amdgcn_s_setprio(1); _Pragma("unroll") for (int m = 0; m < 4; ++m) _Pragma("unroll") for (int n = 0; n < 2; ++n) _Pragma("unroll") for (int k = 0; k < 2; ++k) \
        acc[ai][bj][m][n] = __builtin_amdgcn_mfma_f32_16x16x32_bf16(Bt[n][k], At[m][k], acc[ai][bj][m][n], 0, 0, 0); __builtin_amdgcn_s_setprio(0); } while (0)
#define PG8_WAIT_V(n) asm volatile("s_waitcnt vmcnt(" #n ")" ::: "memory")
#define PG8_WAIT_L(n) asm volatile("s_waitcnt lgkmcnt(" #n ")" ::: "memory")
#define PG8_BAR __builtin_amdgcn_s_barrier()
#define PG8_SCHED __builtin_amdgcn_sched_barrier(0)
    Unit cur, nxt; int ui = 0;
    if (!S.next(0, cur)) return;
    f32x4 acc[2][2][4][2];
#pragma unroll
    for (int a = 0; a < 2; ++a)
#pragma unroll
        for (int b = 0; b < 2; ++b)
#pragma unroll
            for (int m = 0; m < 4; ++m)
#pragma unroll
                for (int n = 0; n < 2; ++n) acc[a][b][m][n] = (f32x4){0.f, 0.f, 0.f, 0.f};
    bf16x8 At[4][2], B0[2][2], B1[2][2];
    const char* cA = (const char*)g.A + (size_t)cur.pm * tstepA; const char* cB = (const char*)g.Bt + (size_t)cur.pn * tstepB;
    if constexpr (SP2) {
        PG8_STAGE(PG8_SB(0, 0), cB, voffB); PG8_STAGE(PG8_SB(0, 1), cB + hstepB, voffB); PG8_STAGE(PG8_SA(0, 0), cA, voffA); PG8_STAGE(PG8_SA(0, 1), cA + hstepA, voffA);
        if (wr == 1) PG8_BAR;
        PG8_WAIT_V(2); PG8_BAR;
        PG8_STAGE(PG8_SB(1, 0), cB + kstep, voffB); PG8_STAGE(PG8_SA(1, 0), cA + kstep, voffA); PG8_STAGE(PG8_SB(1, 1), cB + hstepB + kstep, voffB);
        PG8_WAIT_V(6); PG8_BAR;
    } else {
        PG8_STAGE(PG8_SB(0, 0), cB, voffB); PG8_STAGE(PG8_SA(0, 0), cA, voffA); PG8_STAGE(PG8_SB(0, 1), cB + hstepB, voffB); PG8_STAGE(PG8_SA(0, 1), cA + hstepA, voffA);
        if (wr == 1) PG8_BAR;
        PG8_WAIT_V(4); PG8_BAR;
        PG8_STAGE(PG8_SB(1, 0), cB + kstep, voffB); PG8_STAGE(PG8_SA(1, 0), cA + kstep, voffA); PG8_STAGE(PG8_SB(1, 1), cB + hstepB + kstep, voffB);
        PG8_WAIT_V(6); PG8_BAR;
    }
    for (;;) {
        const bool has_next = S.next(ui + 1, nxt);
        const char* nA = has_next ? (const char*)g.A + (size_t)nxt.pm * tstepA : cA; const char* nB = has_next ? (const char*)g.Bt + (size_t)nxt.pn * tstepB : cB;
#pragma nounroll
        for (int t = 0; t < nt; t += 2) {
            const bool last = (t == nt - 2);
            const char* a1 = cA + (size_t)(t + 1) * kstep;
            const char* a2 = last ? nA : cA + (size_t)(t + 2) * kstep; const char* b2 = last ? nB : cB + (size_t)(t + 2) * kstep;
            const char* a3 = a2 + kstep; const char* b3 = b2 + kstep;
            if constexpr (SP2) {
            PG8_LDB(B0, 0, 0); PG8_LDB(B1, 0, 1); PG8_SCHED; PG8_LDA(At, 0, 0); PG8_STAGE(PG8_SA(1, 1), a1 + hstepA, voffA);
            PG8_WAIT_V(8); PG8_WAIT_L(0); PG8_BAR; PG8_MMA(0, 0, At, B0); PG8_MMA(0, 1, At, B1); PG8_BAR; PG8_SCHED;
            PG8_LDA(At, 0, 1); PG8_STAGE(PG8_SB(0, 0), b2, voffB); PG8_STAGE(PG8_SB(0, 1), b2 + hstepB, voffB); PG8_STAGE(PG8_SA(0, 0), a2, voffA);
            PG8_WAIT_V(8); PG8_WAIT_L(0); PG8_BAR; PG8_MMA(1, 0, At, B0); PG8_MMA(1, 1, At, B1); PG8_BAR; PG8_SCHED;
            PG8_LDB(B0, 1, 0); PG8_LDB(B1, 1, 1); PG8_SCHED; PG8_LDA(At, 1, 0); PG8_STAGE(PG8_SA(0, 1), a2 + hstepA, voffA);
            PG8_WAIT_V(8); PG8_WAIT_L(0); PG8_BAR; PG8_MMA(0, 0, At, B0); PG8_MMA(0, 1, At, B1); PG8_BAR; PG8_SCHED;
            PG8_LDA(At, 1, 1); PG8_STAGE(PG8_SB(1, 0), b3, voffB); PG8_STAGE(PG8_SB(1, 1), b3 + hstepB, voffB); PG8_STAGE(PG8_SA(1, 0), a3, voffA);
            PG8_WAIT_V(8); PG8_WAIT_L(0); PG8_BAR; PG8_MMA(1, 0, At, B0); PG8_MMA(1, 1, At, B1); PG8_BAR; PG8_SCHED;
            } else {
            PG8_LDB(B0, 0, 0); PG8_SCHED; PG8_LDA(At, 0, 0); PG8_STAGE(PG8_SA(1, 1), a1 + hstepA, voffA);
            PG8_WAIT_L(8); PG8_BAR; PG8_WAIT_L(0); PG8_MMA(0, 0, At, B0); PG8_BAR; PG8_SCHED;
            PG8_LDB(B1, 0, 1); PG8_STAGE(PG8_SB(0, 0), b2, voffB);
            PG8_BAR; PG8_WAIT_L(0); PG8_MMA(0, 1, At, B1); PG8_BAR;
            PG8_LDA(At, 0, 1); PG8_STAGE(PG8_SA(0, 0), a2, voffA);
            PG8_BAR; PG8_WAIT_L(0); PG8_MMA(1, 0, At, B0); PG8_BAR; PG8_SCHED;
            PG8_STAGE(PG8_SB(0, 1), b2 + hstepB, voffB);
            PG8_WAIT_V(6); PG8_BAR; PG8_MMA(1, 1, At, B1); PG8_BAR;
            PG8_LDB(B0, 1, 0); PG8_SCHED; PG8_LDA(At, 1, 0); PG8_STAGE(PG8_SA(0, 1), a2 + hstepA, voffA);
            PG8_WAIT_L(8); PG8_BAR; PG8_WAIT_L(0); PG8_MMA(0, 0, At, B0); PG8_BAR; PG8_SCHED;
            PG8_LDB(B1, 1, 1); PG8_STAGE(PG8_SB(1, 0), b3, voffB);
            PG8_BAR; PG8_WAIT_L(0); PG8_MMA(0, 1, At, B1); PG8_BAR;
            PG8_LDA(At, 1, 1); PG8_STAGE(PG8_SA(1, 0), a3, voffA);
            PG8_BAR; PG8_WAIT_L(0); PG8_MMA(1, 0, At, B0); PG8_BAR; PG8_SCHED;
            PG8_STAGE(PG8_SB(1, 1), b3 + hstepB, voffB);
            PG8_WAIT_V(6); PG8_BAR; PG8_MMA(1, 1, At, B1); PG8_BAR;
            }
        }
        if constexpr (ALIGN_EPI) { if (wr == 0) PG8_BAR; }
        E(acc, cur, wr, wc, fr, fq);
        if (!has_next) break;
#pragma unroll
        for (int a = 0; a < 2; ++a)
#pragma unroll
            for (int b = 0; b < 2; ++b)
#pragma unroll
                for (int m = 0; m < 4; ++m)
#pragma unroll
                    for (int n = 0; n < 2; ++n) acc[a][b][m][n] = (f32x4){0.f, 0.f, 0.f, 0.f};
        cur = nxt; cA = nA; cB = nB; ++ui;
        if constexpr (ALIGN_EPI) { if (wr == 1) PG8_BAR; }
    }
    PG8_WAIT_V(0);
    if constexpr (!ALIGN_EPI) { if (wr == 0) PG8_BAR; }
    PG8_BAR;
#undef PG8_SA
#undef PG8_SB
#undef PG8_STAGE
#undef PG8_LDA
#undef PG8_LDB
#undef PG8_MMA
#undef PG8_WAIT_V
#undef PG8_WAIT_L
#undef PG8_BAR
#undef PG8_SCHED
}

#define EPI_ROWS(...) _Pragma("unroll") for (int ai = 0; ai < 2; ++ai) _Pragma("unroll") for (int m = 0; m < 4; ++m) { const int row = u.pm * BM + ai * HALF + wr * 64 + m * 16 + fr; __VA_ARGS__ }
__device__ __forceinline__ u32x4 pack8(f32x4 a, f32x4 b) { u32x4 w; w.x = cvtpk(a[0], a[1]); w.y = cvtpk(a[2], a[3]); w.z = cvtpk(b[0], b[1]); w.w = cvtpk(b[2], b[3]); return w; }
__device__ __forceinline__ u32x2 pack4(f32x4 a) { u32x2 w; w.x = cvtpk(a[0], a[1]); w.y = cvtpk(a[2], a[3]); return w; }
__device__ __forceinline__ float sq4(f32x4 a) { return (a[0] * a[0] + a[1] * a[1]) + (a[2] * a[2] + a[3] * a[3]); }
__device__ __forceinline__ float red_fq(float s) { s += __shfl_xor(s, 16); s += __shfl_xor(s, 32); return s; }

struct EpiMlaA {
    static constexpr bool PERM = false;
    const u64* ss_in; bf16_t* araw; u64* ssq; u64* sskv; bf16_t* kr; const float* rope;
    __device__ __forceinline__ void operator()(const Acc& acc, const Unit& u, int wr, int wc, int fr, int fq) const {
        EPI_ROWS(
            const float rs = 1.0f / sqrtf(ss_get(ss_in + row) * (1.0f / 1024.0f) + NEPS);
            _Pragma("unroll") for (int bj = 0; bj < 2; ++bj) {
                const int cg = u.pn * BM + bj * HALF + wc * 32;
                const f32x4 v0 = acc[ai][bj][m][0] * rs, v1 = acc[ai][bj][m][1] * rs;
                if (cg < 640) {
                    bf16_t* p = araw + (size_t)row * 768 + cg + 4 * fq;
                    *(u32x2*)p = pack4(v0); *(u32x2*)(p + 16) = pack4(v1);
                    const float s = red_fq(sq4(v0) + sq4(v1));
                    if (fq == 0) ss_add((cg < 384 ? ssq : sskv) + row, s);
                } else if (cg == 640) {
                    const f32x4 c = *(const f32x4*)(rope + (size_t)row * 16 + 4 * fq), sn = *(const f32x4*)(rope + (size_t)MTOK * 16 + (size_t)row * 16 + 4 * fq);
                    const f32x4 o1 = v0 * c - v1 * sn, o2 = v1 * c + v0 * sn;
                    bf16_t* p = kr + (size_t)row * 32 + 4 * fq;
                    *(u32x2*)p = pack4(o1); *(u32x2*)(p + 16) = pack4(o2);
                }
            })
    }
};
struct EpiMlaQ {
    static constexpr bool PERM = false;
    const u64* ssq; bf16_t* q; const float* rope;
    __device__ __forceinline__ void operator()(const Acc& acc, const Unit& u, int wr, int wc, int fr, int fq) const {
        EPI_ROWS(
            const float rs = C2_96 / sqrtf(ss_get(ssq + row) * (1.0f / 384.0f) + NEPS);
            _Pragma("unroll") for (int bj = 0; bj < 2; ++bj) {
                const int cg = u.pn * BM + bj * HALF + wc * 32;
                f32x4 v0 = acc[ai][bj][m][0] * rs, v1 = acc[ai][bj][m][1] * rs;
                if ((cg % 96) == 64) {
                    const f32x4 c = *(const f32x4*)(rope + (size_t)row * 16 + 4 * fq), sn = *(const f32x4*)(rope + (size_t)MTOK * 16 + (size_t)row * 16 + 4 * fq);
                    const f32x4 o1 = v0 * c - v1 * sn, o2 = v1 * c + v0 * sn; v0 = o1; v1 = o2;
                }
                bf16_t* p = q + (size_t)row * 1536 + cg + 4 * fq;
                *(u32x2*)p = pack4(v0); *(u32x2*)(p + 16) = pack4(v1);
            })
    }
};
struct EpiMlaKV {
    static constexpr bool PERM = true;
    const u64* sskv; bf16_t* kn; bf16_t* v;
    __device__ __forceinline__ void operator()(const Acc& acc, const Unit& u, int wr, int wc, int fr, int fq) const {
        EPI_ROWS(
            const float rs = 1.0f / sqrtf(ss_get(sskv + row) * (1.0f / 256.0f) + NEPS);
            _Pragma("unroll") for (int bj = 0; bj < 2; ++bj) {
                const int col0 = u.pn * BM + bj * HALF + wc * 32 + 8 * fq, head = col0 >> 7, w = col0 & 127;
                bf16_t* p = (w < 64 ? kn + w : v + (w - 64)) + (size_t)row * 1024 + head * 64;
                *(u32x4*)p = pack8(acc[ai][bj][m][0] * rs, acc[ai][bj][m][1] * rs);
            })
    }
};
__device__ __forceinline__ float lsig(float z) { return fminf(z, 0.f) - __logf(1.0f + __expf(-fabsf(z))); }
struct EpiQKV {
    static constexpr bool PERM = true;
    const u64* ss_in; bf16_t* qp; size_t segstride; int ld; float* lf; const float* bfv;
    __device__ __forceinline__ void operator()(const Acc& acc, const Unit& u, int wr, int wc, int fr, int fq) const {
        EPI_ROWS(
            const float rs = 1.0f / sqrtf(ss_get(ss_in + row) * (1.0f / 1024.0f) + NEPS);
            _Pragma("unroll") for (int bj = 0; bj < 2; ++bj) {
                const int col0 = u.pn * BM + bj * HALF + wc * 32 + 8 * fq, seg = col0 >> 10, w = col0 & 1023;
                if (seg < 3) {
                    const float sc = (seg == 0) ? rs * C2_64 : rs;
                    bf16_t* p = qp + (size_t)seg * segstride + (size_t)row * ld + w;
                    *(u32x4*)p = pack8(acc[ai][bj][m][0] * sc, acc[ai][bj][m][1] * sc);
                } else if (lf != nullptr && col0 < 3088) {
                    const f32x4 z0 = acc[ai][bj][m][0] * rs, z1 = acc[ai][bj][m][1] * rs; const int hb = col0 - 3072; float* lp = lf + (size_t)row * 16 + hb; const float* bp = bfv + hb;
                    lp[0] = lsig(z0[0] + bp[0]); lp[1] = lsig(z0[1] + bp[1]); lp[2] = lsig(z0[2] + bp[2]); lp[3] = lsig(z0[3] + bp[3]);
                    lp[4] = lsig(z1[0] + bp[4]); lp[5] = lsig(z1[1] + bp[5]); lp[6] = lsig(z1[2] + bp[6]); lp[7] = lsig(z1[3] + bp[7]);
                }
            })
    }
};
template <bool SS> struct EpiY {
    static constexpr bool PERM = true;
    bf16_t* y; u64* ss;
    __device__ __forceinline__ void operator()(const Acc& acc, const Unit& u, int wr, int wc, int fr, int fq) const {
        EPI_ROWS(
            float s = 0.f;
            _Pragma("unroll") for (int bj = 0; bj < 2; ++bj) {
                const int col0 = u.pn * BM + bj * HALF + wc * 32 + 8 * fq;
                const f32x4 v0 = acc[ai][bj][m][0], v1 = acc[ai][bj][m][1];
                *(u32x4*)(y + (size_t)row * 1024 + col0) = pack8(v0, v1);
                if (SS) s += sq4(v0) + sq4(v1);
            }
            if (SS) { s = red_fq(s); if (fq == 0) ss_add(ss + row, s); })
    }
};
struct EpiSwiglu {
    static constexpr bool PERM = false;
    bf16_t* act;
    __device__ __forceinline__ void operator()(const Acc& acc, const Unit& u, int wr, int wc, int fr, int fq) const {
        EPI_ROWS(
            _Pragma("unroll") for (int bj = 0; bj < 2; ++bj) {
                const int oc = (u.pn * BM + bj * HALF + wc * 32) / 2 + 4 * fq;
                const f32x4 gt = acc[ai][bj][m][0], up = acc[ai][bj][m][1]; f32x4 r;
                _Pragma("unroll") for (int e = 0; e < 4; ++e) r[e] = gt[e] * sigmoidf_(gt[e]) * up[e];
                *(u32x2*)(act + (size_t)row * DFF + oc) = pack4(r);
            })
    }
};
struct EpiGate {
    static constexpr bool PERM = true;
    float* h; const bf16_t* pp; bf16_t* xn; u64* ss;
    __device__ __forceinline__ void operator()(const Acc& acc, const Unit& u, int wr, int wc, int fr, int fq) const {
        EPI_ROWS(
            float s = 0.f;
            _Pragma("unroll") for (int bj = 0; bj < 2; ++bj) {
                const int col0 = u.pn * BM + bj * HALF + wc * 32 + 8 * fq;
                float* hp = h + (size_t)row * 1024 + col0;
                f32x4 h0 = *(const f32x4*)hp, h1 = *(const f32x4*)(hp + 4);
                const u32x4 pw = *(const u32x4*)(pp + (size_t)row * 1024 + col0);
                const f32x4 p0 = {bf_lo(pw.x), bf_hi(pw.x), bf_lo(pw.y), bf_hi(pw.y)}, p1 = {bf_lo(pw.z), bf_hi(pw.z), bf_lo(pw.w), bf_hi(pw.w)};
                const f32x4 g0 = acc[ai][bj][m][0], g1 = acc[ai][bj][m][1];
                _Pragma("unroll") for (int e = 0; e < 4; ++e) { h0[e] += p0[e] * sigmoidf_(g0[e]); h1[e] += p1[e] * sigmoidf_(g1[e]); }
                *(f32x4*)hp = h0; *(f32x4*)(hp + 4) = h1;
                if (xn) { *(u32x4*)(xn + (size_t)row * 1024 + col0) = pack8(h0, h1); s += sq4(h0) + sq4(h1); }
            }
            if (ss) { s = red_fq(s); if (fq == 0) ss_add(ss + row, s); })
    }
};
#undef EPI_ROWS
}
namespace att {
constexpr int MODE_CAUSAL = 0, MODE_FOX = 1, MODE_DIL = 2;
__device__ __forceinline__ int crow(int r, int hi) { return (r & 3) + 8 * (r >> 2) + 4 * hi; }
typedef short v4i16_t __attribute__((ext_vector_type(4)));
__device__ __forceinline__ s16x4 vtr(const LAS char* p) { return __builtin_bit_cast(s16x4, __builtin_amdgcn_ds_read_tr16_b64_v4i16((LAS v4i16_t*)p)); }

constexpr int KSLOT = 12288, VSLOT = 8192, STREAM_BYTES = 2 * KSLOT + 2 * VSLOT;
constexpr int L_WSF = 2 * STREAM_BYTES;
constexpr int L_OST = L_WSF + 8 * 512;
constexpr int L_TAB = L_OST + 8 * 4096;
static_assert(L_TAB + 8192 <= RING_BYTES, "attention LDS map");

struct Stream {
    const bf16_t* q; const bf16_t* k; const bf16_t* kr; const bf16_t* v; bf16_t* o; float* lse;
    int ldq, ldk, ldv, ldo; int row0, rstep; int qs0  , kt0  , nt  ; int head; int merge;
};

template <int GW, int DK, int MODE>
__device__ __forceinline__ void run_unit(LAS unsigned char* lds, const Stream& S, int wid, int lane) {
    constexpr int NPK = DK / 8;
    constexpr int SPAN = 128;
    const int r32 = lane & 31, hi = lane >> 5;
    const int sidx = (GW == 8) ? 0 : (wid >> 2), wg = (GW == 8) ? wid : (wid & 3);
    LAS unsigned char* sb = lds + sidx * STREAM_BYTES;
    LAS float* wsf = (LAS float*)(lds + L_WSF + wid * 512);
    LAS unsigned char* ost = lds + L_OST + wid * 4096;
    LAS float* tab = (LAS float*)(lds + L_TAB + ((MODE == MODE_DIL) ? sidx * 1024 : 0));
    const int qsw = S.qs0 + wg * 32;
    auto dma_tile = [&](int t, int b) {
        const int kbase = S.kt0 + 64 * t;
        if (kbase + 63 < 0) return;
        {   int ki = kbase + lane; ki = ki < 0 ? 0 : ki; const size_t rowk = (size_t)(S.row0 + ki * S.rstep);
#pragma unroll
            for (int p = wg; p < NPK; p += GW) {
                const bf16_t* src = (p < 8) ? S.k + rowk * S.ldk + p * 8 : S.kr + rowk * 32 + (p - 8) * 8;
                __builtin_amdgcn_global_load_lds((const unsigned*)src, (LAS unsigned*)(sb + b * KSLOT + p * 1024), 16, 0, 0); } }
#pragma unroll
        for (int p = wg; p < 8; p += GW) {
            int ki = kbase + 16 * (p & 3) + (lane >> 2); ki = ki < 0 ? 0 : ki;
            const bf16_t* src = S.v + (size_t)(S.row0 + ki * S.rstep) * S.ldv + (p >> 2) * 32 + (lane & 3) * 8;
            __builtin_amdgcn_global_load_lds((const unsigned*)src, (LAS unsigned*)(sb + 2 * KSLOT + b * VSLOT + p * 1024), 16, 0, 0); }
    };
    dma_tile(0, 0);
    bf16x8 qr[DK / 16];
    { const bf16_t* qp = S.q + (size_t)(S.row0 + (qsw + r32) * S.rstep) * S.ldq + hi * 8;
#pragma unroll
      for (int d0 = 0; d0 < DK / 16; ++d0) qr[d0] = *(const bf16x8*)(qp + d0 * 16); }
    f32x16 o0 = {}, o1 = {};
    float m = -1.0e30f, l = 0.f;
    const int myq = qsw + r32;
    __syncthreads();
    for (int t = 0; t < S.nt; ++t) {
        const int b = t & 1;
        if (t + 1 < S.nt) dma_tile(t + 1, b ^ 1);
        const int kmin = S.kt0 + 64 * t, kmax = kmin + 63;
        bool active = (kmin <= qsw + 31) && (kmax >= 0);
        if (MODE == MODE_DIL) active = active && (kmax >= qsw - SPAN);
        if (active) {
            const LAS unsigned char* Ks = sb + b * KSLOT; const LAS unsigned char* Vs = sb + 2 * KSLOT + b * VSLOT;
            f32x16 p0, p1;
            if (MODE == MODE_FOX) {
#pragma unroll
                for (int r = 0; r < 16; ++r) { p0[r] = tab[kmin + crow(r, hi)]; p1[r] = tab[kmin + 32 + crow(r, hi)]; }
            } else { p0 = f32x16{}; p1 = f32x16{}; }
            const LAS unsigned char* kb = Ks + hi * 1024 + r32 * 16;
#pragma unroll
            for (int d0 = 0; d0 < DK / 16; ++d0) {
                const bf16x8 k0 = *(const LAS bf16x8*)(kb + d0 * 2048), k1 = *(const LAS bf16x8*)(kb + d0 * 2048 + 512);
                p0 = __builtin_amdgcn_mfma_f32_32x32x16_bf16(k0, qr[d0], p0, 0, 0, 0);
                p1 = __builtin_amdgcn_mfma_f32_32x32x16_bf16(k1, qr[d0], p1, 0, 0, 0);
            }
            if (MODE == MODE_DIL) {
#pragma unroll
                for (int r = 0; r < 16; ++r) {
                    const int k0i = kmin + crow(r, hi), k1i = k0i + 32; const int rel0 = myq - k0i, rel1 = myq - k1i;
                    const bool v0 = (rel0 >= 0) && (rel0 <= SPAN) && (k0i >= 0), v1 = (rel1 >= 0) && (rel1 <= SPAN) && (k1i >= 0);
                    const float b0 = tab[v0 ? rel0 : 0], b1 = tab[v1 ? rel1 : 0];
                    p0[r] = v0 ? p0[r] + b0 : -INFINITY; p1[r] = v1 ? p1[r] + b1 : -INFINITY; }
            } else if (kmax > qsw) {
#pragma unroll
                for (int r = 0; r < 16; ++r) { const int k0i = kmin + crow(r, hi);
                    if (k0i > myq) p0[r] = -INFINITY; if (k0i + 32 > myq) p1[r] = -INFINITY; }
            }
            float rm = fmaxf(p0[0], p1[0]);
#pragma unroll
            for (int r = 1; r < 16; ++r) rm = fmaxf(rm, fmaxf(p0[r], p1[r]));
            rm = fmaxf(rm, __shfl_xor(rm, 32));
            const float mn = fmaxf(m, rm);
            const float alpha = __builtin_amdgcn_exp2f(m - mn);
            const bool resc = __any(mn > m);
            m = mn;
            float ls = 0.f;
#pragma unroll
            for (int r = 0; r < 16; ++r) { p0[r] = __builtin_amdgcn_exp2f(p0[r] - mn); p1[r] = __builtin_amdgcn_exp2f(p1[r] - mn); ls += p0[r] + p1[r]; }
            l = l * alpha + ls;
            if (resc) {
                if (hi == 0) wsf[r32] = alpha;
#pragma unroll
                for (int r = 0; r < 16; ++r) { const float a = wsf[crow(r, hi)]; o0[r] *= a; o1[r] *= a; }
            }
            u32x4 pw[4];
#pragma unroll
            for (int j = 0; j < 4; ++j) { pw[0][j] = cvtpk(p0[2 * j], p0[2 * j + 1]); pw[1][j] = cvtpk(p0[8 + 2 * j], p0[8 + 2 * j + 1]);
                                          pw[2][j] = cvtpk(p1[2 * j], p1[2 * j + 1]); pw[3][j] = cvtpk(p1[8 + 2 * j], p1[8 + 2 * j + 1]); }
            const LAS char* vp = (const LAS char*)Vs + ((lane >> 4) & 1) * 32 + (lane & 3) * 8 + (4 * hi + ((lane & 15) >> 2)) * 64;
#pragma unroll
            for (int ks = 0; ks < 4; ++ks) {
                const s16x4 a0 = vtr(vp + ks * 1024), a1 = vtr(vp + ks * 1024 + 512), c0 = vtr(vp + 4096 + ks * 1024), c1 = vtr(vp + 4096 + ks * 1024 + 512);
                const bf16x8 vf0 = {a0[0], a0[1], a0[2], a0[3], a1[0], a1[1], a1[2], a1[3]}, vf1 = {c0[0], c0[1], c0[2], c0[3], c1[0], c1[1], c1[2], c1[3]};
                const bf16x8 pa = __builtin_bit_cast(bf16x8, pw[ks]);
                o0 = __builtin_amdgcn_mfma_f32_32x32x16_bf16(pa, vf0, o0, 0, 0, 0);
                o1 = __builtin_amdgcn_mfma_f32_32x32x16_bf16(pa, vf1, o1, 0, 0, 0);
            }
        }
        __syncthreads();
    }
    l += __shfl_xor(l, 32);
    if (hi == 0) { wsf[r32] = 1.0f / l; wsf[32 + r32] = m + __builtin_amdgcn_logf(l); }
    LAS bf16_t* stg = (LAS bf16_t*)ost;
#pragma unroll
    for (int r = 0; r < 16; ++r) { const float il = wsf[crow(r, hi)]; const int orow = crow(r, hi);
        stg[orow * 64 + r32] = (bf16_t)(cvtpk(o0[r] * il, 0.f) & 0xffffu); stg[orow * 64 + 32 + r32] = (bf16_t)(cvtpk(o1[r] * il, 0.f) & 0xffffu); }
    asm volatile("s_waitcnt lgkmcnt(0)" ::: "memory");
#pragma unroll
    for (int i = 0; i < 4; ++i) {
        const int row = i * 8 + (lane >> 3), ch = lane & 7;
        u32x4 vnew = *(const LAS u32x4*)(stg + row * 64 + ch * 8);
        const size_t grow = (size_t)(S.row0 + (qsw + row) * S.rstep);
        bf16_t* op = S.o + grow * S.ldo + ch * 8;
        if (MODE == MODE_DIL) {
            const float ln = wsf[32 + row]; float* lp = S.lse + grow * 16 + S.head;
            if (S.merge) {
                const float lo = *lp; const u32x4 vold = *(const u32x4*)op;
                const float mx = fmaxf(lo, ln), wo = __builtin_amdgcn_exp2f(lo - mx), wn = __builtin_amdgcn_exp2f(ln - mx), inv = 1.0f / (wo + wn), a = wo * inv, c = wn * inv;
                u32x4 res;
#pragma unroll
                for (int e = 0; e < 4; ++e) res[e] = cvtpk(a * bf_lo(vold[e]) + c * bf_lo(vnew[e]), a * bf_hi(vold[e]) + c * bf_hi(vnew[e]));
                vnew = res;
                if (ch == 0) *lp = mx + __builtin_amdgcn_logf(wo + wn);
            } else if (ch == 0) *lp = ln;
        }
        *(u32x4*)op = vnew;
    }
    __syncthreads();
}
}
namespace cg = cooperative_groups;
constexpr int NTHREADS = 512, NWAVES = 8;
constexpr int N_PHASES = 39;

struct Ctx {
    LAS unsigned char* lds; int tid, lane, wave, vcu, G, gw, ngw;
    const __attribute__((address_space(4))) void* ka; float* H; unsigned char* ws; int bx;
};
__device__ __forceinline__ const float* INP(const Ctx& C, int i) { return ((const float* const __attribute__((address_space(4)))*)C.ka)[i]; }
__device__ __forceinline__ Ctx make_ctx(LAS unsigned char* lds) {
    Ctx C; C.lds = lds; int tid = threadIdx.x; asm volatile("" : "+v"(tid)); C.tid = tid; C.lane = tid & 63; C.wave = __builtin_amdgcn_readfirstlane(tid >> 6);
    int G = gridDim.x, bx = blockIdx.x; asm volatile("" : "+s"(G), "+s"(bx)); C.G = G; C.bx = bx; C.vcu = (G % 8 == 0) ? (bx % 8) * (G / 8) + bx / 8 : bx;
    C.gw = C.vcu * NWAVES + C.wave; C.ngw = G * NWAVES;
    const __attribute__((address_space(4))) void* ka = (const __attribute__((address_space(4))) void*)__builtin_amdgcn_kernarg_segment_ptr(); asm volatile("" : "+s"(ka)); C.ka = ka;
    C.H = ((const __attribute__((address_space(4))) Args*)ka)->out; C.ws = ((const __attribute__((address_space(4))) Args*)ka)->ws; return C;
}
__device__ __forceinline__ u64* ss_arr(const Ctx& C, int idx) { return (u64*)(C.ws + WS_SS) + (size_t)idx * MTOK; }

__device__ __forceinline__ void cvt_mixer(const Ctx& C, int layer) {
    LAS float* scr = (LAS float*)(C.lds + C.wave * 16384);
    const int mixer = layer % 3, j = layer / 3; const float* g0 = INP(C, 3) + (size_t)layer * 4096;
    bf16_t* wmix = (bf16_t*)(C.ws + WS_WMIX); bf16_t* wo = (bf16_t*)(C.ws + WS_WO);
    if (mixer == 0) {
        cvt_run(CvtJob{INP(C, 9) + (size_t)j * 1024 * 672, wmix, g0, 1024, 672, 768, 0}, scr, C.gw, C.ngw, C.lane);
        cvt_run(CvtJob{INP(C, 12) + (size_t)j * 384 * 1536, (bf16_t*)(C.ws + WS_WMIX + 2 * MiB), INP(C, 10) + j * 384, 384, 1536, 1536, 0}, scr, C.gw, C.ngw, C.lane);
        cvt_run(CvtJob{INP(C, 13) + (size_t)j * 256 * 2048, (bf16_t*)(C.ws + WS_WMIX + 4 * MiB), INP(C, 11) + j * 256, 256, 2048, 2048, 0}, scr, C.gw, C.ngw, C.lane);
        cvt_run(CvtJob{INP(C, 14) + (size_t)j * 1024 * 1024, wo, nullptr, 1024, 1024, 1024, 0}, scr, C.gw, C.ngw, C.lane);
    } else if (mixer == 1) {
        cvt_run(CvtJob{INP(C, 15) + (size_t)j * 1024 * 9216, wmix, g0, 1024, 9216, 9216, 0}, scr, C.gw, C.ngw, C.lane);
        cvt_run(CvtJob{INP(C, 16) + (size_t)j * 1024 * 1024, wo, nullptr, 1024, 1024, 1024, 0}, scr, C.gw, C.ngw, C.lane);
    } else {
        cvt_run(CvtJob{INP(C, 17) + (size_t)j * 1024 * 3088, wmix, g0, 1024, 3088, 3328, 0}, scr, C.gw, C.ngw, C.lane);
        cvt_run(CvtJob{INP(C, 19) + (size_t)j * 1024 * 1024, wo, nullptr, 1024, 1024, 1024, 0}, scr, C.gw, C.ngw, C.lane);
    }
}
__device__ __forceinline__ void cvt_ffn(const Ctx& C, int layer) {
    LAS float* scr = (LAS float*)(C.lds + C.wave * 16384);
    cvt_run(CvtJob{INP(C, 4) + (size_t)layer * 1024 * 5632, (bf16_t*)(C.ws + WS_WIN), nullptr, 1024, 5632, 5632, 1}, scr, C.gw, C.ngw, C.lane);
    cvt_run(CvtJob{INP(C, 5) + (size_t)layer * 2816 * 1024, (bf16_t*)(C.ws + WS_WOUT), nullptr, 2816, 1024, 1024, 0}, scr, C.gw, C.ngw, C.lane);
}
__device__ __forceinline__ void cvt_ple(const Ctx& C, int layer) {
    LAS float* scr = (LAS float*)(C.lds + C.wave * 16384);
    cvt_run(CvtJob{INP(C, 6) + (size_t)layer * 256 * 1024, (bf16_t*)(C.ws + WS_WPROJ), nullptr, 256, 1024, 1024, 0}, scr, C.gw, C.ngw, C.lane);
    cvt_run(CvtJob{INP(C, 7) + (size_t)layer * 1024 * 1024, (bf16_t*)(C.ws + WS_WGATE), nullptr, 1024, 1024, 1024, 0}, scr, C.gw, C.ngw, C.lane);
}

__device__ __forceinline__ int t5_bucket(int dist) {
    if (dist < 16) return dist;
    const float n = (float)dist;
    int large = 16 + (int)(logf(n / 16.0f) / 4.852030263919617f * 16.0f);
    return large < 31 ? large : 31;
}

struct Row16 { f32x4 a[4]; };
__device__ __forceinline__ Row16 ld_row_f32(const float* p, int lane) { Row16 r; const f32x4* q = (const f32x4*)(p + 8 * lane); r.a[0] = q[0]; r.a[1] = q[1]; q = (const f32x4*)(p + 512 + 8 * lane); r.a[2] = q[0]; r.a[3] = q[1]; return r; }
__device__ __forceinline__ void st_row_f32(float* p, int lane, const Row16& r) { f32x4* q = (f32x4*)(p + 8 * lane); q[0] = r.a[0]; q[1] = r.a[1]; q = (f32x4*)(p + 512 + 8 * lane); q[0] = r.a[2]; q[1] = r.a[3]; }
__device__ __forceinline__ Row16 ld_row_bf16(const bf16_t* p, int lane) { Row16 r; const u32x4 w0 = *(const u32x4*)(p + 8 * lane), w1 = *(const u32x4*)(p + 512 + 8 * lane);
    r.a[0] = (f32x4){bf_lo(w0.x), bf_hi(w0.x), bf_lo(w0.y), bf_hi(w0.y)}; r.a[1] = (f32x4){bf_lo(w0.z), bf_hi(w0.z), bf_lo(w0.w), bf_hi(w0.w)};
    r.a[2] = (f32x4){bf_lo(w1.x), bf_hi(w1.x), bf_lo(w1.y), bf_hi(w1.y)}; r.a[3] = (f32x4){bf_lo(w1.z), bf_hi(w1.z), bf_lo(w1.w), bf_hi(w1.w)}; return r; }
__device__ __forceinline__ void st_row_bf16(bf16_t* p, int lane, const Row16& r) { *(u32x4*)(p + 8 * lane) = pg8::pack8(r.a[0], r.a[1]); *(u32x4*)(p + 512 + 8 * lane) = pg8::pack8(r.a[2], r.a[3]); }
__device__ __forceinline__ float row_ss(const Row16& r) { return wave_sum((pg8::sq4(r.a[0]) + pg8::sq4(r.a[1])) + (pg8::sq4(r.a[2]) + pg8::sq4(r.a[3]))); }

__device__ __forceinline__ void ph_prologue(const Ctx& C) {
    { u32x4* z = (u32x4*)(C.ws + WS_SS); for (int i = C.gw * 64 + C.lane; i < (int)(2 * MiB / 16); i += C.ngw * 64) z[i] = (u32x4){0u, 0u, 0u, 0u}; }
    cvt_mixer(C, 0); cvt_ffn(C, 0); cvt_ple(C, 0);
    { float* rc = (float*)(C.ws + WS_ROPE); const int* pos = (const int*)INP(C, 2);
      for (int i = C.gw * 64 + C.lane; i < MTOK * 16; i += C.ngw * 64) { const int row = i >> 4, f = i & 15;
          const float inv = powf(10000.0f, -(float)f / 16.0f); const float ang = (float)pos[row] * inv;
          const double ad = (double)ang, twopi = 6.283185307179586476925; const float r = (float)(ad - rint(ad / twopi) * twopi);
          rc[i] = cosf(r); rc[MTOK * 16 + i] = sinf(r); } }
    { float* bt = (float*)(C.ws + WS_BIAS); const float* rb = INP(C, 8);
      for (int i = C.gw * 64 + C.lane; i < 3 * 16 * 132; i += C.ngw * 64) { const int g = i / (16 * 132), h = (i / 132) % 16, rel = i % 132; const int d = (g == 0) ? 1 : (g == 1) ? 4 : 16;
          bt[i] = (rel <= 128) ? rb[t5_bucket(rel * d) * 48 + g * 16 + h] * LOG2E : 0.f; } }
    { const float* x = INP(C, 0); bf16_t* xn1 = (bf16_t*)(C.ws + WS_XN1); u64* ss = ss_arr(C, SS_IN + 0);
      for (int row = C.gw; row < MTOK; row += C.ngw) { const Row16 r = ld_row_f32(x + (size_t)row * 1024, C.lane);
          st_row_f32(C.H + (size_t)row * 1024, C.lane, r); st_row_bf16(xn1 + (size_t)row * 1024, C.lane, r);
          const float s = row_ss(r); if (C.lane == 0) ss[row] = (u64)(s * SS_SCALE + 0.5f); } }
}
__device__ __forceinline__ void ph_r1(const Ctx& C, int layer) {
    const bf16_t* y = (const bf16_t*)(C.ws + WS_BIG + BIG_Y); bf16_t* xn0 = (bf16_t*)(C.ws + WS_XN0); const u64* ssy = ss_arr(C, SS_Y1 + layer);
    const float* g1 = INP(C, 3) + (size_t)layer * 4096 + 1024; const float* g2 = g1 + 1024;
    const Row16 G1 = ld_row_f32(g1, C.lane), G2 = ld_row_f32(g2, C.lane);
    for (int row = C.gw; row < MTOK; row += C.ngw) {
        Row16 h = ld_row_f32(C.H + (size_t)row * 1024, C.lane); const Row16 yv = ld_row_bf16(y + (size_t)row * 1024, C.lane);
        const float rs = 1.0f / sqrtf(ss_get(ssy + row) * (1.0f / 1024.0f) + NEPS);
#pragma unroll
        for (int i = 0; i < 4; ++i) h.a[i] += yv.a[i] * rs * G1.a[i];
        st_row_f32(C.H + (size_t)row * 1024, C.lane, h);
        const float rs2 = 1.0f / sqrtf(row_ss(h) * (1.0f / 1024.0f) + NEPS);
#pragma unroll
        for (int i = 0; i < 4; ++i) h.a[i] = h.a[i] * rs2 * G2.a[i];
        st_row_bf16(xn0 + (size_t)row * 1024, C.lane, h);
    }
    if (layer + 1 < 4) cvt_mixer(C, layer + 1);
    if (layer > 0) cvt_ple(C, layer);
}
__device__ __forceinline__ void ph_r2(const Ctx& C, int layer) {
    const bf16_t* y = (const bf16_t*)(C.ws + WS_BIG + BIG_Y2); bf16_t* xn0 = (bf16_t*)(C.ws + WS_XN0); const u64* ssy = ss_arr(C, SS_Y2 + layer);
    const float* g3 = INP(C, 3) + (size_t)layer * 4096 + 3072; const Row16 G3 = ld_row_f32(g3, C.lane);
    const float* p = INP(C, 1) + (size_t)layer * MTOK * 256; bf16_t* pbf = (bf16_t*)(C.ws + WS_BIG + BIG_PBF);
    for (int row = C.gw; row < MTOK; row += C.ngw) {
        Row16 h = ld_row_f32(C.H + (size_t)row * 1024, C.lane); const Row16 yv = ld_row_bf16(y + (size_t)row * 1024, C.lane);
        const float rs = 1.0f / sqrtf(ss_get(ssy + row) * (1.0f / 1024.0f) + NEPS);
#pragma unroll
        for (int i = 0; i < 4; ++i) h.a[i] += yv.a[i] * rs * G3.a[i];
        st_row_f32(C.H + (size_t)row * 1024, C.lane, h); st_row_bf16(xn0 + (size_t)row * 1024, C.lane, h);
        const f32x4 pv = *(const f32x4*)(p + (size_t)row * 256 + 4 * C.lane);
        *(u32x2*)(pbf + (size_t)row * 256 + 4 * C.lane) = pg8::pack4(pv);
    }
    if (layer + 1 < 4) cvt_ffn(C, layer + 1);
}
template <class Epi> __device__ __forceinline__ void run_gemm(const Ctx& C, const bf16_t* A, int lda, const bf16_t* Bt, int ldb, int N, int K, const Epi& E) {
    pg8::Gemm g{A, Bt, lda, ldb, MTOK, N, K}; pg8::StaticOrder S; S.init(MTOK, N, C.G, C.bx);
    pg8::gemm_phase<Epi, true, true>(C.lds, g, S, E, C.tid);
}
template <int DK, int MODE> __device__ __forceinline__ void ph_attn_causal(const Ctx& C) {
    const int bh = C.vcu >> 1, b = bh >> 4, h = bh & 15, s = C.vcu & 1;
    if (MODE == att::MODE_FOX) {
        LAS float* tab = (LAS float*)(C.lds + att::L_TAB); LAS float* wt = (LAS float*)(C.lds + att::L_WSF);
        const float* lf = (const float*)(C.ws + WS_LF) + (size_t)b * SEQL * 16 + h;
        float c[4]; float run = 0.f;
#pragma unroll
        for (int e = 0; e < 4; ++e) { run += lf[(size_t)(4 * C.tid + e) * 16]; c[e] = run; }
        float sc = run;
#pragma unroll
        for (int o = 1; o < 64; o <<= 1) { const float v = __shfl_up(sc, o); if (C.lane >= o) sc += v; }
        if (C.lane == 63) wt[C.wave] = sc;
        __syncthreads();
        float base = sc - run;
        for (int w = 0; w < C.wave; ++w) base += wt[w];
#pragma unroll
        for (int e = 0; e < 4; ++e) tab[4 * C.tid + e] = -(base + c[e]) * LOG2E;
        __syncthreads();
    }
    for (int i = 0; i < 4; ++i) {
        const int qb = (i == 0) ? 7 - s : (i == 1) ? s : (i == 2) ? 5 - s : 2 + s;
        att::Stream S;
        if (DK == 96) { S.q = (const bf16_t*)(C.ws + WS_BIG + BIG_Q) + h * 96; S.ldq = 1536; S.k = (const bf16_t*)(C.ws + WS_BIG + BIG_KN) + h * 64; S.v = (const bf16_t*)(C.ws + WS_BIG + BIG_V) + h * 64; S.kr = (const bf16_t*)(C.ws + WS_KR); }
        else { S.q = (const bf16_t*)(C.ws + WS_BIG + BIG_FQ) + h * 64; S.ldq = 1024; S.k = (const bf16_t*)(C.ws + WS_BIG + BIG_FK) + h * 64; S.v = (const bf16_t*)(C.ws + WS_BIG + BIG_FV) + h * 64; S.kr = nullptr; }
        S.ldk = 1024; S.ldv = 1024; S.o = (bf16_t*)(C.ws + WS_BIG + BIG_O) + h * 64; S.ldo = 1024; S.lse = nullptr;
        S.row0 = b * SEQL; S.rstep = 1; S.qs0 = 256 * qb; S.kt0 = 0; S.nt = 4 * (qb + 1); S.head = h; S.merge = 0;
        att::run_unit<8, DK, MODE>(C.lds, S, C.wave, C.lane);
    }
}
__device__ __forceinline__ void ph_attn_dil(const Ctx& C, int g) {
    const int bh = C.vcu >> 1, b = bh >> 4, h = bh & 15; const int d = (g == 0) ? 1 : (g == 1) ? 4 : 16;
    { const float* bt = (const float*)(C.ws + WS_BIAS) + (size_t)(g * 16 + h) * 132; LAS float* tab = (LAS float*)(C.lds + att::L_TAB);
      if (C.tid < 132) { const float v = bt[C.tid]; tab[C.tid] = v; tab[256 + C.tid] = v; }
      __syncthreads(); }
    const bf16_t* qkv = (const bf16_t*)(C.ws + WS_BIG + BIG_QKVG);
    for (int i = 0; i < 4; ++i) {
        const int su = 8 * C.vcu + 2 * i + (C.wave >> 2), x = su & 15;
        const int r = (d == 1) ? 0 : (d == 4) ? (x & 3) : x, n = (d == 1) ? x : (d == 4) ? (x >> 2) : 0;
        att::Stream S;
        S.q = qkv + h * 64; S.k = qkv + 1024 + h * 64; S.v = qkv + 2048 + h * 64; S.kr = nullptr; S.ldq = 3072; S.ldk = 3072; S.ldv = 3072;
        S.o = (bf16_t*)(C.ws + WS_BIG + BIG_O) + h * 64; S.ldo = 1024; S.lse = (float*)(C.ws + WS_LSE);
        S.row0 = b * SEQL + r; S.rstep = d; S.qs0 = 128 * n; S.kt0 = 128 * n - 128; S.nt = 4; S.head = h; S.merge = (g > 0);
        att::run_unit<4, 64, att::MODE_DIL>(C.lds, S, C.wave, C.lane);
    }
}
__device__ __forceinline__ void ph_common(const Ctx& C, int layer, int st) {
    unsigned char* big = C.ws + WS_BIG;
    switch (st) {
    case 0: run_gemm(C, (const bf16_t*)(big + BIG_O), 1024, (const bf16_t*)(C.ws + WS_WO), 1024, 1024, 1024, pg8::EpiY<true>{(bf16_t*)(big + BIG_Y), ss_arr(C, SS_Y1 + layer)}); break;
    case 1: ph_r1(C, layer); break;
    case 2: run_gemm(C, (const bf16_t*)(C.ws + WS_XN0), 1024, (const bf16_t*)(C.ws + WS_WIN), 1024, 5632, 1024, pg8::EpiSwiglu{(bf16_t*)(big + BIG_ACT)}); break;
    case 3: run_gemm(C, (const bf16_t*)(big + BIG_ACT), DFF, (const bf16_t*)(C.ws + WS_WOUT), DFF, 1024, DFF, pg8::EpiY<true>{(bf16_t*)(big + BIG_Y2), ss_arr(C, SS_Y2 + layer)}); break;
    case 4: ph_r2(C, layer); break;
    default: {
        run_gemm(C, (const bf16_t*)(big + BIG_PBF), 256, (const bf16_t*)(C.ws + WS_WPROJ), 256, 1024, 256, pg8::EpiY<false>{(bf16_t*)(big + BIG_PP), nullptr});
        asm volatile("s_waitcnt vmcnt(0)" ::: "memory"); __builtin_amdgcn_fence(__ATOMIC_RELEASE, "agent"); asm volatile("s_waitcnt vmcnt(0)" ::: "memory");
        __syncthreads(); __builtin_amdgcn_fence(__ATOMIC_ACQUIRE, "agent"); asm volatile("s_waitcnt vmcnt(0)" ::: "memory"); __syncthreads();
        const bool lastl = (layer == 3); const Ctx C2 = make_ctx(C.lds);
        run_gemm(C2, (const bf16_t*)(C2.ws + WS_XN0), 1024, (const bf16_t*)(C2.ws + WS_WGATE), 1024, 1024, 1024,
                 pg8::EpiGate{C2.H, (const bf16_t*)(C2.ws + WS_BIG + BIG_PP), lastl ? nullptr : (bf16_t*)(C2.ws + WS_XN1), lastl ? nullptr : ss_arr(C2, SS_IN + layer + 1)});
    } }
}
__device__ __forceinline__ void run_phase(const Ctx& C, int ph) {
    if (ph == 0) { ph_prologue(C); return; }
    int layer, st;
    if (ph < 10) { layer = 0; st = ph - 1; } else if (ph < 22) { layer = 1; st = ph - 10; } else if (ph < 30) { layer = 2; st = ph - 22; } else { layer = 3; st = ph - 30; }
    const int mixer = layer % 3, j = layer / 3;
    unsigned char* big = C.ws + WS_BIG; const bf16_t* xn1 = (const bf16_t*)(C.ws + WS_XN1); const u64* ss_in = ss_arr(C, SS_IN + layer);
    if (mixer == 0) {
        if (st == 0) run_gemm(C, xn1, 1024, (const bf16_t*)(C.ws + WS_WMIX), 1024, 768, 1024,
                              pg8::EpiMlaA{ss_in, (bf16_t*)(big + BIG_ARAW), ss_arr(C, SS_Q + j), ss_arr(C, SS_KV + j), (bf16_t*)(C.ws + WS_KR), (const float*)(C.ws + WS_ROPE)});
        else if (st == 1) {
            run_gemm(C, (const bf16_t*)(big + BIG_ARAW), 768, (const bf16_t*)(C.ws + WS_WMIX + 2 * MiB), 384, 1536, 384, pg8::EpiMlaQ{ss_arr(C, SS_Q + j), (bf16_t*)(big + BIG_Q), (const float*)(C.ws + WS_ROPE)});
            const Ctx C2 = make_ctx(C.lds);
            run_gemm(C2, (const bf16_t*)(C2.ws + WS_BIG + BIG_ARAW) + 384, 768, (const bf16_t*)(C2.ws + WS_WMIX + 4 * MiB), 256, 2048, 256, pg8::EpiMlaKV{ss_arr(C2, SS_KV + j), (bf16_t*)(C2.ws + WS_BIG + BIG_KN), (bf16_t*)(C2.ws + WS_BIG + BIG_V)});
        } else if (st == 2) ph_attn_causal<96, att::MODE_CAUSAL>(C);
        else ph_common(C, layer, st - 3);
    } else if (mixer == 1) {
        if (st < 6) { const int g = st >> 1;
            if ((st & 1) == 0) { bf16_t* qkv = (bf16_t*)(big + BIG_QKVG);
                run_gemm(C, xn1, 1024, (const bf16_t*)(C.ws + WS_WMIX) + (size_t)g * 3072 * 1024, 1024, 3072, 1024, pg8::EpiQKV{ss_in, qkv, (size_t)1024, 3072, nullptr, nullptr});
            } else ph_attn_dil(C, g);
        } else ph_common(C, layer, st - 6);
    } else {
        if (st == 0) run_gemm(C, xn1, 1024, (const bf16_t*)(C.ws + WS_WMIX), 1024, 3328, 1024,
                              pg8::EpiQKV{ss_in, (bf16_t*)(big + BIG_FQ), (size_t)(BIG_FK - BIG_FQ) / 2, 1024, (float*)(C.ws + WS_LF), INP(C, 18) + j * 16});
        else if (st == 1) ph_attn_causal<64, att::MODE_FOX>(C);
        else ph_common(C, layer, st - 2);
    }
}

__global__ void __launch_bounds__(NTHREADS, 2) mega_fwd(Args args) {
    extern __shared__ __attribute__((aligned(16))) unsigned char lds_raw[];
    for (int ph = args.ph_lo; ph < args.ph_hi; ++ph) {
        { const Ctx C = make_ctx((LAS unsigned char*)lds_raw); run_phase(C, ph); }
        if (ph + 1 < args.ph_hi) { cg::this_grid().sync(); }
    }
}
#ifndef MK_MODE
#define MK_MODE 0
#endif
#if MK_MODE == 2
__global__ void dbg_compare(const float* a, const float* ref, int n, unsigned* flag, int stage, float tol2) {
    __shared__ float s1[1024], s2[1024];
    float e = 0.f, r = 0.f; bool bad = false;
    for (int i = threadIdx.x; i < n; i += 1024) { const float d = a[i] - ref[i]; e += d * d; r += ref[i] * ref[i]; if (!(fabsf(a[i]) < 1e30f)) bad = true; }
    s1[threadIdx.x] = bad ? 1e30f : e; s2[threadIdx.x] = r; __syncthreads();
    for (int o = 512; o > 0; o >>= 1) { if ((int)threadIdx.x < o) { s1[threadIdx.x] += s1[threadIdx.x + o]; s2[threadIdx.x] += s2[threadIdx.x + o]; } __syncthreads(); }
    if (threadIdx.x == 0) { if (!(s1[0] <= tol2 * s2[0])) atomicMin(flag, (unsigned)stage); }
}
__global__ void dbg_final(float* out, int n, const unsigned* flag) {
    const unsigned f = *flag; if (f == 0xffffffffu) return;
    for (int i = blockIdx.x * blockDim.x + threadIdx.x; i < n; i += gridDim.x * blockDim.x) out[i] = (i == 0) ? 1000.0f * (float)(f + 1) : 0.f;
}
#endif
extern "C" void kernel_launch(void* const* d_in, const int* in_sizes, int n_in, void* d_out, int out_size, void* d_ws, size_t ws_size, hipStream_t stream) {
    static int grid = 0;
    if (grid == 0) {
        int dev = 0, cus = 0, per_cu = 0;
        if (n_in != 20 || out_size != MTOK * DMODEL || ws_size < WS_END + (MK_MODE == 2 ? 64 * MiB : 0)) { fprintf(stderr, "kernel_launch: unexpected problem geometry (n_in %d out %d ws %zu)\n", n_in, out_size, ws_size); grid = -1; return; }
        (void)hipGetDevice(&dev); (void)hipDeviceGetAttribute(&cus, hipDeviceAttributeMultiprocessorCount, dev);
        if (hipFuncSetAttribute((const void*)mega_fwd, hipFuncAttributeMaxDynamicSharedMemorySize, LDS_BYTES) != hipSuccess) { fprintf(stderr, "kernel_launch: hipFuncSetAttribute failed\n"); grid = -1; return; }
        if (hipOccupancyMaxActiveBlocksPerMultiprocessor(&per_cu, (const void*)mega_fwd, NTHREADS, LDS_BYTES) != hipSuccess || per_cu < 1) { fprintf(stderr, "kernel_launch: occupancy query says %d blocks per CU\n", per_cu); grid = -1; (void)hipGetLastError(); return; }
        grid = cus;
        if (grid != 256) { fprintf(stderr, "kernel_launch: built for a 256-CU device, found %d CUs\n", cus); grid = -1; return; }
    }
    if (grid < 0) return;
    Args a{};
    for (int i = 0; i < 20; ++i) a.in[i] = (const float*)d_in[i];
    a.out = (float*)d_out; a.ws = (unsigned char*)d_ws;
#if MK_MODE == 0
    a.ph_lo = 0; a.ph_hi = N_PHASES;
    void* kargs[] = {&a};
    hipError_t e = hipLaunchCooperativeKernel((const void*)mega_fwd, dim3(grid), dim3(NTHREADS), kargs, LDS_BYTES, stream);
    if (e != hipSuccess) fprintf(stderr, "kernel_launch: cooperative launch failed: %s\n", hipGetErrorString(e));
#else
#if MK_MODE == 2
    unsigned char* ws = (unsigned char*)d_ws;
    float* ck = (float*)(ws + WS_END);
    unsigned* flag = (unsigned*)(ws + WS_CTL);
    (void)hipMemsetAsync(flag, 0xff, 4, stream);
    const size_t CKB = (size_t)SEQL * DMODEL * 4;
#endif
#ifndef PH_LIMIT
#define PH_LIMIT N_PHASES
#endif
    for (int ph = 0; ph < PH_LIMIT; ++ph) {
        a.ph_lo = ph; a.ph_hi = ph + 1;
        hipLaunchKernelGGL(mega_fwd, dim3(grid), dim3(NTHREADS), LDS_BYTES, stream, a);
#if MK_MODE == 2
        int k = -1;
        if (ph == 5) k = 0; else if (ph == 9) k = 1; else if (ph == 17) k = 2; else if (ph == 21) k = 3; else if (ph == 25) k = 4; else if (ph == 29) k = 5; else if (ph == 34) k = 6; else if (ph == 38) k = 7;
        if (k >= 0) (void)hipMemcpyAsync((char*)ck + k * CKB, d_out, CKB, hipMemcpyDeviceToDevice, stream);
#endif
    }
#if MK_MODE == 2
    nv::In I;
    I.x = (const float*)d_in[0]; I.p = (const float*)d_in[1]; I.pos = (const int*)d_in[2]; I.norm_g = (const float*)d_in[3];
    I.ffn_in = (const float*)d_in[4]; I.ffn_out = (const float*)d_in[5]; I.ple_proj = (const float*)d_in[6]; I.ple_gate = (const float*)d_in[7];
    I.rel_bias = (const float*)d_in[8]; I.mla_a = (const float*)d_in[9]; I.mla_qn = (const float*)d_in[10]; I.mla_kvn = (const float*)d_in[11];
    I.mla_uq = (const float*)d_in[12]; I.mla_ukv = (const float*)d_in[13]; I.mla_o = (const float*)d_in[14]; I.dil_qkv = (const float*)d_in[15];
    I.dil_o = (const float*)d_in[16]; I.fox_qkvf = (const float*)d_in[17]; I.fox_bf = (const float*)d_in[18]; I.fox_o = (const float*)d_in[19];
    float* nvh = (float*)(ws + WS_XN0);
    float* scr = (float*)(ws + WS_BIG);
    for (int i = 0; i < 4; ++i) {
        (void)hipMemcpyAsync(nvh, i == 0 ? (const void*)I.x : (const void*)((char*)ck + (2 * (i - 1) + 1) * CKB), CKB, hipMemcpyDeviceToDevice, stream);
        nv::dbg_mid = (float*)((char*)ck + (2 * i) * CKB); nv::dbg_flag = flag; nv::dbg_stage = 2 * i;
        nv::run_batch(stream, I, 0, nvh, scr, i, i + 1);
        hipLaunchKernelGGL(dbg_compare, dim3(1), dim3(1024), 0, stream, (const float*)((char*)ck + (2 * i + 1) * CKB), (const float*)nvh, SEQL * DMODEL, flag, 2 * i + 1, DBG_TOL2);
    }
    hipLaunchKernelGGL(dbg_final, dim3(1024), dim3(256), 0, stream, (float*)d_out, MTOK * DMODEL, (const unsigned*)flag);
#endif
#endif
}
```

```cpp
#include <hip/hip_runtime.h>
#include <hip/hip_cooperative_groups.h>
#include <cstdio>
#include <cstdint>
#include <cmath>
#define MK_MODE 0
#define LAS __attribute__((address_space(3)))
#define GAS __attribute__((address_space(1)))
typedef unsigned short bf16_t;
typedef short bf16x8 __attribute__((ext_vector_type(8)));
typedef short s16x4 __attribute__((ext_vector_type(4)));
typedef float f32x2 __attribute__((ext_vector_type(2)));
typedef float f32x4 __attribute__((ext_vector_type(4)));
typedef float f32x16 __attribute__((ext_vector_type(16)));
typedef unsigned u32x2 __attribute__((ext_vector_type(2)));
typedef unsigned u32x4 __attribute__((ext_vector_type(4)));
typedef __bf16 bf16x2_t __attribute__((ext_vector_type(2)));

constexpr int MTOK = 16384, DMODEL = 1024, SEQL = 2048, NBATCH = 8, DFF = 2816;
constexpr float NEPS = 1e-6f;
constexpr float LOG2E = 1.4426950408889634f;
constexpr float C2_64 = 0.125f * LOG2E;
constexpr float C2_96 = 0.10206207261596575f * LOG2E;

__device__ __forceinline__ unsigned cvtpk(float lo, float hi) { f32x2 v = {lo, hi}; bf16x2_t b = __builtin_convertvector(v, bf16x2_t); return __builtin_bit_cast(unsigned, b); }
__device__ __forceinline__ float bf_lo(unsigned u) { return __uint_as_float(u << 16); }
__device__ __forceinline__ float bf_hi(unsigned u) { return __uint_as_float(u & 0xffff0000u); }
__device__ __forceinline__ float wave_sum(float v) {
#pragma unroll
    for (int o = 1; o < 64; o <<= 1) v += __shfl_xor(v, o);
    return v;
}
typedef unsigned long long u64;
constexpr float SS_SCALE = 16777216.0f, SS_INV = 1.0f / 16777216.0f;
__device__ __forceinline__ void ss_add(u64* p, float s) { atomicAdd(p, (u64)(s * SS_SCALE + 0.5f)); }
__device__ __forceinline__ float ss_get(const u64* p) { return (float)(*p) * SS_INV; }
__device__ __forceinline__ float sigmoidf_(float x) { return 1.0f / (1.0f + __expf(-x)); }

constexpr size_t MiB = 1u << 20;
constexpr size_t WS_CTL = 0;
constexpr size_t WS_SS = 1 * MiB;
constexpr size_t WS_ROPE = 3 * MiB;
constexpr size_t WS_BIAS = 5 * MiB;
constexpr size_t WS_LF = 6 * MiB;
constexpr size_t WS_LSE = 7 * MiB;
constexpr size_t WS_KR = 26 * MiB;
constexpr size_t WS_WMIX = 8 * MiB;
constexpr size_t WS_WO = 27 * MiB;
constexpr size_t WS_WIN = 30 * MiB;
constexpr size_t WS_WOUT = 41 * MiB;
constexpr size_t WS_WPROJ = 47 * MiB;
constexpr size_t WS_WGATE = 48 * MiB;
constexpr size_t WS_XN0 = 50 * MiB;
constexpr size_t WS_XN1 = 82 * MiB;
constexpr size_t WS_BIG = 114 * MiB;
constexpr size_t BIG_ARAW = 0, BIG_Q = 24 * MiB, BIG_KN = 72 * MiB, BIG_V = 104 * MiB;
constexpr size_t BIG_FQ = 0, BIG_FK = 32 * MiB, BIG_FV = 64 * MiB;
constexpr size_t BIG_QKVG = 0;
constexpr size_t BIG_O = 136 * MiB, BIG_Y = 24 * MiB;
constexpr size_t BIG_ACT = 0, BIG_Y2 = 96 * MiB, BIG_PP = 128 * MiB, BIG_PBF = 0;
constexpr size_t WS_END = WS_BIG + 168 * MiB;
constexpr int SS_IN = 0  , SS_Y1 = 4  , SS_Y2 = 8  , SS_Q = 12  , SS_KV = 14  ;

constexpr int RING_BYTES = 131072;
constexpr int LDS_BYTES = 147456;

struct Args { const float* in[20]; float* out; unsigned char* ws; int ph_lo, ph_hi; };

__device__ __forceinline__ int wrow_map(int n, int mode) {
    if (mode == 0) return n;
    const int up = n >= DFF, c = up ? n - DFF : n;
    return 32 * (c >> 4) + (up ? 16 : 0) + (c & 15);
}
__device__ __forceinline__ void cvt_item(const float* W, int K, int N, bf16_t* WT, const float* gv, int mode, LAS float* scr, int item, int lane) {
    const int nblk = (N + 31) / 32, kb = item / nblk, nb = item % nblk, k0 = 64 * kb, n0 = 32 * nb;
    const int nn = lane & 31; const bool nok = (n0 + nn) < N;
#pragma unroll 8
    for (int i = 0; i < 32; ++i) { const int kk = 2 * i + (lane >> 5);
        float v = nok ? W[(size_t)(k0 + kk) * N + n0 + nn] : 0.f; if (gv) v *= gv[k0 + kk];
        scr[kk * 33 + nn] = v; }
    asm volatile("s_waitcnt lgkmcnt(0)" ::: "memory");
    const int c = lane & 7;
#pragma unroll
    for (int j = 0; j < 4; ++j) { const int n = (lane >> 3) + 8 * j; const LAS float* s = scr + (8 * c) * 33 + n;
        u32x4 o; o.x = cvtpk(s[0 * 33], s[1 * 33]); o.y = cvtpk(s[2 * 33], s[3 * 33]); o.z = cvtpk(s[4 * 33], s[5 * 33]); o.w = cvtpk(s[6 * 33], s[7 * 33]);
        if (n0 + n < N) *(u32x4*)(WT + (size_t)wrow_map(n0 + n, mode) * K + k0 + 8 * c) = o; }
    asm volatile("s_waitcnt lgkmcnt(0)" ::: "memory");
}
struct CvtJob { const float* W; bf16_t* WT; const float* gv; int K, N, Npad, mode; };
__device__ __forceinline__ void cvt_run(const CvtJob& J, LAS float* scr, int gw, int ngw, int lane) {
    if (J.W == nullptr) return;
    const int nitems = (J.K / 64) * ((J.N + 31) / 32);
    for (int it = gw; it < nitems; it += ngw) cvt_item(J.W, J.K, J.N, J.WT, J.gv, J.mode, scr, it, lane);
    const int padrows = J.Npad - J.N; const int chunks = padrows * (J.K / 8);
    for (int c = gw * 64 + lane; c < chunks; c += ngw * 64) { const int r = c / (J.K / 8), cc = c % (J.K / 8);
        *(u32x4*)(J.WT + (size_t)(J.N + r) * J.K + cc * 8) = (u32x4){0u, 0u, 0u, 0u}; }
}
namespace pg8 {
constexpr int BM = 256, BK = 64, HALF = 128, HTB = HALF * BK * 2, STAGE_BYTES = 8 * HTB, NXCD = 8, WGM = 8;
__device__ __forceinline__ int lds_byte(int r, int c) { const int st = (r >> 4) * 2 + (c >> 5), rr = r & 15, cc = c & 31, ob = rr * 64 + cc * 2; return st * 1024 + (ob ^ (((ob >> 9) & 1) << 5)); }
__device__ __forceinline__ void stage_rc(int b, int& R, int& C) { const int st = b / 1024, sb = b % 1024, swz = sb ^ (((sb >> 9) & 1) << 5); R = (st >> 1) * 16 + swz / 64; C = (st & 1) * 32 + (swz % 64) / 2; }
__device__ __forceinline__ int perm32(int rho) { const int n = rho >> 4, i = rho & 15; return 8 * (i >> 2) + 4 * n + (i & 3); }

struct Unit { int pm, pn; };
struct Gemm { const bf16_t* A; const bf16_t* Bt; int lda, ldb, M, N, K; };

struct StaticOrder {
    int nM, nN, nwg, G, c;
    __device__ void init(int M, int N, int G_, int c_) { nM = M / BM; nN = N / BM; nwg = nM * nN; G = G_; c = c_; }
    __device__ bool next(int i, Unit& u) const {
        const long L = (long)i * G + c; if (L >= nwg) return false;
        int wgid = (int)L; { const int q = nwg / NXCD, r = nwg % NXCD, xcd = wgid % NXCD, off = wgid / NXCD; wgid = (xcd < r ? xcd * (q + 1) : r * (q + 1) + (xcd - r) * q) + off; }
        const int nig = WGM * nN, gid = wgid / nig, fm = gid * WGM, gsz = (nM - fm) < WGM ? (nM - fm) : WGM;
        u.pm = fm + ((wgid % nig) % gsz); u.pn = (wgid % nig) / gsz; return true;
    }
};

typedef f32x4 Acc[2][2][4][2];

template <class Epi, bool ALIGN_EPI, bool SP2>
__device__ __forceinline__ void gemm_phase(LAS unsigned char* lds, const Gemm g, const StaticOrder& S, const Epi& E, const int tid) {
    const int wid = __builtin_amdgcn_readfirstlane(tid >> 6), lane = tid & 63, wr = wid >> 2, wc = wid & 3, fr = lane & 15, fq = lane >> 4;
    int K = g.K; asm volatile("" : "+s"(K)); const int nt = K / BK;
    unsigned voffA[2], voffB[2];
#pragma unroll
    for (int i = 0; i < 2; ++i) { int R, C; stage_rc(tid * 16 + i * 8192, R, C); const int Rb = Epi::PERM ? ((R & ~31) + perm32(R & 31)) : R;
        voffA[i] = (unsigned)(R * g.lda + C) * 2u; voffB[i] = (unsigned)(Rb * g.ldb + C) * 2u; }
    const size_t kstep = (size_t)(BK * 2);
    const size_t hstepA = (size_t)HALF * g.lda * 2, hstepB = (size_t)HALF * g.ldb * 2;
    const size_t tstepA = 2 * hstepA, tstepB = 2 * hstepB;
    const unsigned ldsw = (unsigned)wid * 1024u;
    const int aoff = lds_byte(wr * 64 + fr, fq * 8), boff = lds_byte(wc * 32 + fr, fq * 8);
#define PG8_SA(b, h) (((b) * 2 + (h)) * HTB)
#define PG8_SB(b, h) ((4 + (b) * 2 + (h)) * HTB)
#define PG8_STAGE(bufoff, gbase, voff) do { _Pragma("unroll") for (int _i = 0; _i < 2; ++_i) \
        __builtin_amdgcn_global_load_lds((const unsigned*)((const char*)(gbase) + (voff)[_i]), (LAS unsigned*)(lds + (bufoff) + ldsw + _i * 8192), 16, 0, 0); } while (0)
#define PG8_LDA(dst, b, h) do { _Pragma("unroll") for (int m = 0; m < 4; ++m) _Pragma("unroll") for (int k = 0; k < 2; ++k) dst[m][k] = *(const LAS bf16x8*)(lds + PG8_SA(b, h) + aoff + m * 2048 + k * 1024); } while (0)
#define PG8_LDB(dst, b, h) do { _Pragma("unroll") for (int n = 0; n < 2; ++n) _Pragma("unroll") for (int k = 0; k < 2; ++k) dst[n][k] = *(const LAS bf16x8*)(lds + PG8_SB(b, h) + boff + n * 2048 + k * 1024); } while (0)
#define PG8_MMA(ai, bj, At, Bt) do { __builtin_amdgcn_s_setprio(1); _Pragma("unroll") for (int m = 0; m < 4; ++m) _Pragma("unroll") for (int n = 0; n < 2; ++n) _Pragma("unroll") for (int k = 0; k < 2; ++k) \
        acc[ai][bj][m][n] = __builtin_amdgcn_mfma_f32_16x16x32_bf16(Bt[n][k], At[m][k], acc[ai][bj][m][n], 0, 0, 0); __builtin_amdgcn_s_setprio(0); } while (0)
#define PG8_WAIT_V(n) asm volatile("s_waitcnt vmcnt(" #n ")" ::: "memory")
#define PG8_WAIT_L(n) asm volatile("s_waitcnt lgkmcnt(" #n ")" ::: "memory")
#define PG8_BAR __builtin_amdgcn_s_barrier()
#define PG8_SCHED __builtin_amdgcn_sched_barrier(0)
    Unit cur, nxt; int ui = 0;
    if (!S.next(0, cur)) return;
    f32x4 acc[2][2][4][2];
#pragma unroll
    for (int a = 0; a < 2; ++a)
#pragma unroll
        for (int b = 0; b < 2; ++b)
#pragma unroll
            for (int m = 0; m < 4; ++m)
#pragma unroll
                for (int n = 0; n < 2; ++n) acc[a][b][m][n] = (f32x4){0.f, 0.f, 0.f, 0.f};
    bf16x8 At[4][2], B0[2][2], B1[2][2];
    const char* cA = (const char*)g.A + (size_t)cur.pm * tstepA; const char* cB = (const char*)g.Bt + (size_t)cur.pn * tstepB;
    if constexpr (SP2) {
        PG8_STAGE(PG8_SB(0, 0), cB, voffB); PG8_STAGE(PG8_SB(0, 1), cB + hstepB, voffB); PG8_STAGE(PG8_SA(0, 0), cA, voffA); PG8_STAGE(PG8_SA(0, 1), cA + hstepA, voffA);
        if (wr == 1) PG8_BAR;
        PG8_WAIT_V(2); PG8_BAR;
        PG8_STAGE(PG8_SB(1, 0), cB + kstep, voffB); PG8_STAGE(PG8_SA(1, 0), cA + kstep, voffA); PG8_STAGE(PG8_SB(1, 1), cB + hstepB + kstep, voffB);
        PG8_WAIT_V(6); PG8_BAR;
    } else {
        PG8_STAGE(PG8_SB(0, 0), cB, voffB); PG8_STAGE(PG8_SA(0, 0), cA, voffA); PG8_STAGE(PG8_SB(0, 1), cB + hstepB, voffB); PG8_STAGE(PG8_SA(0, 1), cA + hstepA, voffA);
        if (wr == 1) PG8_BAR;
        PG8_WAIT_V(4); PG8_BAR;
        PG8_STAGE(PG8_SB(1, 0), cB + kstep, voffB); PG8_STAGE(PG8_SA(1, 0), cA + kstep, voffA); PG8_STAGE(PG8_SB(1, 1), cB + hstepB + kstep, voffB);
        PG8_WAIT_V(6); PG8_BAR;
    }
    for (;;) {
        const bool has_next = S.next(ui + 1, nxt);
        const char* nA = has_next ? (const char*)g.A + (size_t)nxt.pm * tstepA : cA; const char* nB = has_next ? (const char*)g.Bt + (size_t)nxt.pn * tstepB : cB;
#pragma nounroll
        for (int t = 0; t < nt; t += 2) {
            const bool last = (t == nt - 2);
            const char* a1 = cA + (size_t)(t + 1) * kstep;
            const char* a2 = last ? nA : cA + (size_t)(t + 2) * kstep; const char* b2 = last ? nB : cB + (size_t)(t + 2) * kstep;
            const char* a3 = a2 + kstep; const char* b3 = b2 + kstep;
            if constexpr (SP2) {
            PG8_LDB(B0, 0, 0); PG8_LDB(B1, 0, 1); PG8_SCHED; PG8_LDA(At, 0, 0); PG8_STAGE(PG8_SA(1, 1), a1 + hstepA, voffA);
            PG8_WAIT_V(8); PG8_WAIT_L(0); PG8_BAR; PG8_MMA(0, 0, At, B0); PG8_MMA(0, 1, At, B1); PG8_BAR; PG8_SCHED;
            PG8_LDA(At, 0, 1); PG8_STAGE(PG8_SB(0, 0), b2, voffB); PG8_STAGE(PG8_SB(0, 1), b2 + hstepB, voffB); PG8_STAGE(PG8_SA(0, 0), a2, voffA);
            PG8_WAIT_V(8); PG8_WAIT_L(0); PG8_BAR; PG8_MMA(1, 0, At, B0); PG8_MMA(1, 1, At, B1); PG8_BAR; PG8_SCHED;
            PG8_LDB(B0, 1, 0); PG8_LDB(B1, 1, 1); PG8_SCHED; PG8_LDA(At, 1, 0); PG8_STAGE(PG8_SA(0, 1), a2 + hstepA, voffA);
            PG8_WAIT_V(8); PG8_WAIT_L(0); PG8_BAR; PG8_MMA(0, 0, At, B0); PG8_MMA(0, 1, At, B1); PG8_BAR; PG8_SCHED;
            PG8_LDA(At, 1, 1); PG8_STAGE(PG8_SB(1, 0), b3, voffB); PG8_STAGE(PG8_SB(1, 1), b3 + hstepB, voffB); PG8_STAGE(PG8_SA(1, 0), a3, voffA);
            PG8_WAIT_V(8); PG8_WAIT_L(0); PG8_BAR; PG8_MMA(1, 0, At, B0); PG8_MMA(1, 1, At, B1); PG8_BAR; PG8_SCHED;
            } else {
            PG8_LDB(B0, 0, 0); PG8_SCHED; PG8_LDA(At, 0, 0); PG8_STAGE(PG8_SA(1, 1), a1 + hstepA, voffA);
            PG8_WAIT_L(8); PG8_BAR; PG8_WAIT_L(0); PG8_MMA(0, 0, At, B0); PG8_BAR; PG8_SCHED;
            PG8_LDB(B1, 0, 1); PG8_STAGE(PG8_SB(0, 0), b2, voffB);
            PG8_BAR; PG8_WAIT_L(0); PG8_MMA(0, 1, At, B1); PG8_BAR;
            PG8_LDA(At, 0, 1); PG8_STAGE(PG8_SA(0, 0), a2, voffA);
            PG8_BAR; PG8_WAIT_L(0); PG8_MMA(1, 0, At, B0); PG8_BAR; PG8_SCHED;
            PG8_STAGE(PG8_SB(0, 1), b2 + hstepB, voffB);
            PG8_WAIT_V(6); PG8_BAR; PG8_MMA(1, 1, At, B1); PG8_BAR;
            PG8_LDB(B0, 1, 0); PG8_SCHED; PG8_LDA(At, 1, 0); PG8_STAGE(PG8_SA(0, 1), a2 + hstepA, voffA);
            PG8_WAIT_L(8); PG8_BAR; PG8_WAIT_L(0); PG8_MMA(0, 0, At, B0); PG8_BAR; PG8_SCHED;
            PG8_LDB(B1, 1, 1); PG8_STAGE(PG8_SB(1, 0), b3, voffB);
            PG8_BAR; PG8_WAIT_L(0); PG8_MMA(0, 1, At, B1); PG8_BAR;
            PG8_LDA(At, 1, 1); PG8_STAGE(PG8_SA(1, 0), a3, voffA);
            PG8_BAR; PG8_WAIT_L(0); PG8_MMA(1, 0, At, B0); PG8_BAR; PG8_SCHED;
            PG8_STAGE(PG8_SB(1, 1), b3 + hstepB, voffB);
            PG8_WAIT_V(6); PG8_BAR; PG8_MMA(1, 1, At, B1); PG8_BAR;
            }
        }
        if constexpr (ALIGN_EPI) { if (wr == 0) PG8_BAR; }
        E(acc, cur, wr, wc, fr, fq);
        if (!has_next) break;
#pragma unroll
        for (int a = 0; a < 2; ++a)
#pragma unroll
            for (int b = 0; b < 2; ++b)
#pragma unroll
                for (int m = 0; m < 4; ++m)
#pragma unroll
                    for (int n = 0; n < 2; ++n) acc[a][b][m][n] = (f32x4){0.f, 0.f, 0.f, 0.f};
        cur = nxt; cA = nA; cB = nB; ++ui;
        if constexpr (ALIGN_EPI) { if (wr == 1) PG8_BAR; }
    }
    PG8_WAIT_V(0);
    if constexpr (!ALIGN_EPI) { if (wr == 0) PG8_BAR; }
    PG8_BAR;
#undef PG8_SA
#undef PG8_SB
#undef PG8_STAGE
#undef PG8_LDA
#undef PG8_LDB
#undef PG8_MMA
#undef PG8_WAIT_V
#undef PG8_WAIT_L
#undef PG8_BAR
#undef PG8_SCHED
}

#define EPI_ROWS(...) _Pragma("unroll") for (int ai = 0; ai < 2; ++ai) _Pragma("unroll") for (int m = 0; m < 4; ++m) { const int row = u.pm * BM + ai * HALF + wr * 64 + m * 16 + fr; __VA_ARGS__ }
__device__ __forceinline__ u32x4 pack8(f32x4 a, f32x4 b) { u32x4 w; w.x = cvtpk(a[0], a[1]); w.y = cvtpk(a[2], a[3]); w.z = cvtpk(b[0], b[1]); w.w = cvtpk(b[2], b[3]); return w; }
__device__ __forceinline__ u32x2 pack4(f32x4 a) { u32x2 w; w.x = cvtpk(a[0], a[1]); w.y = cvtpk(a[2], a[3]); return w; }
__device__ __forceinline__ float sq4(f32x4 a) { return (a[0] * a[0] + a[1] * a[1]) + (a[2] * a[2] + a[3] * a[3]); }
__device__ __forceinline__ float red_fq(float s) { s += __shfl_xor(s, 16); s += __shfl_xor(s, 32); return s; }

struct EpiMlaA {
    static constexpr bool PERM = false;
    const u64* ss_in; bf16_t* araw; u64* ssq; u64* sskv; bf16_t* kr; const float* rope;
    __device__ __forceinline__ void operator()(const Acc& acc, const Unit& u, int wr, int wc, int fr, int fq) const {
        EPI_ROWS(
            const float rs = 1.0f / sqrtf(ss_get(ss_in + row) * (1.0f / 1024.0f) + NEPS);
            _Pragma("unroll") for (int bj = 0; bj < 2; ++bj) {
                const int cg = u.pn * BM + bj * HALF + wc * 32;
                const f32x4 v0 = acc[ai][bj][m][0] * rs, v1 = acc[ai][bj][m][1] * rs;
                if (cg < 640) {
                    bf16_t* p = araw + (size_t)row * 768 + cg + 4 * fq;
                    *(u32x2*)p = pack4(v0); *(u32x2*)(p + 16) = pack4(v1);
                    const float s = red_fq(sq4(v0) + sq4(v1));
                    if (fq == 0) ss_add((cg < 384 ? ssq : sskv) + row, s);
                } else if (cg == 640) {
                    const f32x4 c = *(const f32x4*)(rope + (size_t)row * 16 + 4 * fq), sn = *(const f32x4*)(rope + (size_t)MTOK * 16 + (size_t)row * 16 + 4 * fq);
                    const f32x4 o1 = v0 * c - v1 * sn, o2 = v1 * c + v0 * sn;
                    bf16_t* p = kr + (size_t)row * 32 + 4 * fq;
                    *(u32x2*)p = pack4(o1); *(u32x2*)(p + 16) = pack4(o2);
                }
            })
    }
};
struct EpiMlaQ {
    static constexpr bool PERM = false;
    const u64* ssq; bf16_t* q; const float* rope;
    __device__ __forceinline__ void operator()(const Acc& acc, const Unit& u, int wr, int wc, int fr, int fq) const {
        EPI_ROWS(
            const float rs = C2_96 / sqrtf(ss_get(ssq + row) * (1.0f / 384.0f) + NEPS);
            _Pragma("unroll") for (int bj = 0; bj < 2; ++bj) {
                const int cg = u.pn * BM + bj * HALF + wc * 32;
                f32x4 v0 = acc[ai][bj][m][0] * rs, v1 = acc[ai][bj][m][1] * rs;
                if ((cg % 96) == 64) {
                    const f32x4 c = *(const f32x4*)(rope + (size_t)row * 16 + 4 * fq), sn = *(const f32x4*)(rope + (size_t)MTOK * 16 + (size_t)row * 16 + 4 * fq);
                    const f32x4 o1 = v0 * c - v1 * sn, o2 = v1 * c + v0 * sn; v0 = o1; v1 = o2;
                }
                bf16_t* p = q + (size_t)row * 1536 + cg + 4 * fq;
                *(u32x2*)p = pack4(v0); *(u32x2*)(p + 16) = pack4(v1);
            })
    }
};
struct EpiMlaKV {
    static constexpr bool PERM = true;
    const u64* sskv; bf16_t* kn; bf16_t* v;
    __device__ __forceinline__ void operator()(const Acc& acc, const Unit& u, int wr, int wc, int fr, int fq) const {
        EPI_ROWS(
            const float rs = 1.0f / sqrtf(ss_get(sskv + row) * (1.0f / 256.0f) + NEPS);
            _Pragma("unroll") for (int bj = 0; bj < 2; ++bj) {
                const int col0 = u.pn * BM + bj * HALF + wc * 32 + 8 * fq, head = col0 >> 7, w = col0 & 127;
                bf16_t* p = (w < 64 ? kn + w : v + (w - 64)) + (size_t)row * 1024 + head * 64;
                *(u32x4*)p = pack8(acc[ai][bj][m][0] * rs, acc[ai][bj][m][1] * rs);
            })
    }
};
__device__ __forceinline__ float lsig(float z) { return fminf(z, 0.f) - __logf(1.0f + __expf(-fabsf(z))); }
struct EpiQKV {
    static constexpr bool PERM = true;
    const u64* ss_in; bf16_t* qp; size_t segstride; int ld; float* lf; const float* bfv;
    __device__ __forceinline__ void operator()(const Acc& acc, const Unit& u, int wr, int wc, int fr, int fq) const {
        EPI_ROWS(
            const float rs = 1.0f / sqrtf(ss_get(ss_in + row) * (1.0f / 1024.0f) + NEPS);
            _Pragma("unroll") for (int bj = 0; bj < 2; ++bj) {
                const int col0 = u.pn * BM + bj * HALF + wc * 32 + 8 * fq, seg = col0 >> 10, w = col0 & 1023;
                if (seg < 3) {
                    const float sc = (seg == 0) ? rs * C2_64 : rs;
                    bf16_t* p = qp + (size_t)seg * segstride + (size_t)row * ld + w;
                    *(u32x4*)p = pack8(acc[ai][bj][m][0] * sc, acc[ai][bj][m][1] * sc);
                } else if (lf != nullptr && col0 < 3088) {
                    const f32x4 z0 = acc[ai][bj][m][0] * rs, z1 = acc[ai][bj][m][1] * rs; const int hb = col0 - 3072; float* lp = lf + (size_t)row * 16 + hb; const float* bp = bfv + hb;
                    lp[0] = lsig(z0[0] + bp[0]); lp[1] = lsig(z0[1] + bp[1]); lp[2] = lsig(z0[2] + bp[2]); lp[3] = lsig(z0[3] + bp[3]);
                    lp[4] = lsig(z1[0] + bp[4]); lp[5] = lsig(z1[1] + bp[5]); lp[6] = lsig(z1[2] + bp[6]); lp[7] = lsig(z1[3] + bp[7]);
                }
            })
    }
};
template <bool SS> struct EpiY {
    static constexpr bool PERM = true;
    bf16_t* y; u64* ss;
    __device__ __forceinline__ void operator()(const Acc& acc, const Unit& u, int wr, int wc, int fr, int fq) const {
        EPI_ROWS(
            float s = 0.f;
            _Pragma("unroll") for (int bj = 0; bj < 2; ++bj) {
                const int col0 = u.pn * BM + bj * HALF + wc * 32 + 8 * fq;
                const f32x4 v0 = acc[ai][bj][m][0], v1 = acc[ai][bj][m][1];
                *(u32x4*)(y + (size_t)row * 1024 + col0) = pack8(v0, v1);
                if (SS) s += sq4(v0) + sq4(v1);
            }
            if (SS) { s = red_fq(s); if (fq == 0) ss_add(ss + row, s); })
    }
};
struct EpiSwiglu {
    static constexpr bool PERM = false;
    bf16_t* act;
    __device__ __forceinline__ void operator()(const Acc& acc, const Unit& u, int wr, int wc, int fr, int fq) const {
        EPI_ROWS(
            _Pragma("unroll") for (int bj = 0; bj < 2; ++bj) {
                const int oc = (u.pn * BM + bj * HALF + wc * 32) / 2 + 4 * fq;
                const f32x4 gt = acc[ai][bj][m][0], up = acc[ai][bj][m][1]; f32x4 r;
                _Pragma("unroll") for (int e = 0; e < 4; ++e) r[e] = gt[e] * sigmoidf_(gt[e]) * up[e];
                *(u32x2*)(act + (size_t)row * DFF + oc) = pack4(r);
            })
    }
};
struct EpiGate {
    static constexpr bool PERM = true;
    float* h; const bf16_t* pp; bf16_t* xn; u64* ss;
    __device__ __forceinline__ void operator()(const Acc& acc, const Unit& u, int wr, int wc, int fr, int fq) const {
        EPI_ROWS(
            float s = 0.f;
            _Pragma("unroll") for (int bj = 0; bj < 2; ++bj) {
                const int col0 = u.pn * BM + bj * HALF + wc * 32 + 8 * fq;
                float* hp = h + (size_t)row * 1024 + col0;
                f32x4 h0 = *(const f32x4*)hp, h1 = *(const f32x4*)(hp + 4);
                const u32x4 pw = *(const u32x4*)(pp + (size_t)row * 1024 + col0);
                const f32x4 p0 = {bf_lo(pw.x), bf_hi(pw.x), bf_lo(pw.y), bf_hi(pw.y)}, p1 = {bf_lo(pw.z), bf_hi(pw.z), bf_lo(pw.w), bf_hi(pw.w)};
                const f32x4 g0 = acc[ai][bj][m][0], g1 = acc[ai][bj][m][1];
                _Pragma("unroll") for (int e = 0; e < 4; ++e) { h0[e] += p0[e] * sigmoidf_(g0[e]); h1[e] += p1[e] * sigmoidf_(g1[e]); }
                *(f32x4*)hp = h0; *(f32x4*)(hp + 4) = h1;
                if (xn) { *(u32x4*)(xn + (size_t)row * 1024 + col0) = pack8(h0, h1); s += sq4(h0) + sq4(h1); }
            }
            if (ss) { s = red_fq(s); if (fq == 0) ss_add(ss + row, s); })
    }
};
#undef EPI_ROWS
}
namespace att {
constexpr int MODE_CAUSAL = 0, MODE_FOX = 1, MODE_DIL = 2;
__device__ __forceinline__ int crow(int r, int hi) { return (r & 3) + 8 * (r >> 2) + 4 * hi; }
typedef short v4i16_t __attribute__((ext_vector_type(4)));
__device__ __forceinline__ s16x4 vtr(const LAS char* p) { return __builtin_bit_cast(s16x4, __builtin_amdgcn_ds_read_tr16_b64_v4i16((LAS v4i16_t*)p)); }

constexpr int KSLOT = 12288, VSLOT = 8192, STREAM_BYTES = 2 * KSLOT + 2 * VSLOT;
constexpr int L_WSF = 2 * STREAM_BYTES;
constexpr int L_OST = L_WSF + 8 * 512;
constexpr int L_TAB = L_OST + 8 * 4096;
static_assert(L_TAB + 8192 <= RING_BYTES, "attention LDS map");

struct Stream {
    const bf16_t* q; const bf16_t* k; const bf16_t* kr; const bf16_t* v; bf16_t* o; float* lse;
    int ldq, ldk, ldv, ldo; int row0, rstep; int qs0  , kt0  , nt  ; int head; int merge;
};

template <int GW, int DK, int MODE>
__device__ __forceinline__ void run_unit(LAS unsigned char* lds, const Stream& S, int wid, int lane) {
    constexpr int NPK = DK / 8;
    constexpr int SPAN = 128;
    const int r32 = lane & 31, hi = lane >> 5;
    const int sidx = (GW == 8) ? 0 : (wid >> 2), wg = (GW == 8) ? wid : (wid & 3);
    LAS unsigned char* sb = lds + sidx * STREAM_BYTES;
    LAS float* wsf = (LAS float*)(lds + L_WSF + wid * 512);
    LAS unsigned char* ost = lds + L_OST + wid * 4096;
    LAS float* tab = (LAS float*)(lds + L_TAB + ((MODE == MODE_DIL) ? sidx * 1024 : 0));
    const int qsw = S.qs0 + wg * 32;
    auto dma_tile = [&](int t, int b) {
        const int kbase = S.kt0 + 64 * t;
        if (kbase + 63 < 0) return;
        {   int ki = kbase + lane; ki = ki < 0 ? 0 : ki; const size_t rowk = (size_t)(S.row0 + ki * S.rstep);
#pragma unroll
            for (int p = wg; p < NPK; p += GW) {
                const bf16_t* src = (p < 8) ? S.k + rowk * S.ldk + p * 8 : S.kr + rowk * 32 + (p - 8) * 8;
                __builtin_amdgcn_global_load_lds((const unsigned*)src, (LAS unsigned*)(sb + b * KSLOT + p * 1024), 16, 0, 0); } }
#pragma unroll
        for (int p = wg; p < 8; p += GW) {
            int ki = kbase + 16 * (p & 3) + (lane >> 2); ki = ki < 0 ? 0 : ki;
            const bf16_t* src = S.v + (size_t)(S.row0 + ki * S.rstep) * S.ldv + (p >> 2) * 32 + (lane & 3) * 8;
            __builtin_amdgcn_global_load_lds((const unsigned*)src, (LAS unsigned*)(sb + 2 * KSLOT + b * VSLOT + p * 1024), 16, 0, 0); }
    };
    dma_tile(0, 0);
    bf16x8 qr[DK / 16];
    { const bf16_t* qp = S.q + (size_t)(S.row0 + (qsw + r32) * S.rstep) * S.ldq + hi * 8;
#pragma unroll
      for (int d0 = 0; d0 < DK / 16; ++d0) qr[d0] = *(const bf16x8*)(qp + d0 * 16); }
    f32x16 o0 = {}, o1 = {};
    float m = -1.0e30f, l = 0.f;
    const int myq = qsw + r32;
    __syncthreads();
    for (int t = 0; t < S.nt; ++t) {
        const int b = t & 1;
        if (t + 1 < S.nt) dma_tile(t + 1, b ^ 1);
        const int kmin = S.kt0 + 64 * t, kmax = kmin + 63;
        bool active = (kmin <= qsw + 31) && (kmax >= 0);
        if (MODE == MODE_DIL) active = active && (kmax >= qsw - SPAN);
        if (active) {
            const LAS unsigned char* Ks = sb + b * KSLOT; const LAS unsigned char* Vs = sb + 2 * KSLOT + b * VSLOT;
            f32x16 p0, p1;
            if (MODE == MODE_FOX) {
#pragma unroll
                for (int r = 0; r < 16; ++r) { p0[r] = tab[kmin + crow(r, hi)]; p1[r] = tab[kmin + 32 + crow(r, hi)]; }
            } else { p0 = f32x16{}; p1 = f32x16{}; }
            const LAS unsigned char* kb = Ks + hi * 1024 + r32 * 16;
#pragma unroll
            for (int d0 = 0; d0 < DK / 16; ++d0) {
                const bf16x8 k0 = *(const LAS bf16x8*)(kb + d0 * 2048), k1 = *(const LAS bf16x8*)(kb + d0 * 2048 + 512);
                p0 = __builtin_amdgcn_mfma_f32_32x32x16_bf16(k0, qr[d0], p0, 0, 0, 0);
                p1 = __builtin_amdgcn_mfma_f32_32x32x16_bf16(k1, qr[d0], p1, 0, 0, 0);
            }
            if (MODE == MODE_DIL) {
#pragma unroll
                for (int r = 0; r < 16; ++r) {
                    const int k0i = kmin + crow(r, hi), k1i = k0i + 32; const int rel0 = myq - k0i, rel1 = myq - k1i;
                    const bool v0 = (rel0 >= 0) && (rel0 <= SPAN) && (k0i >= 0), v1 = (rel1 >= 0) && (rel1 <= SPAN) && (k1i >= 0);
                    const float b0 = tab[v0 ? rel0 : 0], b1 = tab[v1 ? rel1 : 0];
                    p0[r] = v0 ? p0[r] + b0 : -INFINITY; p1[r] = v1 ? p1[r] + b1 : -INFINITY; }
            } else if (kmax > qsw) {
#pragma unroll
                for (int r = 0; r < 16; ++r) { const int k0i = kmin + crow(r, hi);
                    if (k0i > myq) p0[r] = -INFINITY; if (k0i + 32 > myq) p1[r] = -INFINITY; }
            }
            float rm = fmaxf(p0[0], p1[0]);
#pragma unroll
            for (int r = 1; r < 16; ++r) rm = fmaxf(rm, fmaxf(p0[r], p1[r]));
            rm = fmaxf(rm, __shfl_xor(rm, 32));
            const float mn = fmaxf(m, rm);
            const float alpha = __builtin_amdgcn_exp2f(m - mn);
            const bool resc = __any(mn > m);
            m = mn;
            float ls = 0.f;
#pragma unroll
            for (int r = 0; r < 16; ++r) { p0[r] = __builtin_amdgcn_exp2f(p0[r] - mn); p1[r] = __builtin_amdgcn_exp2f(p1[r] - mn); ls += p0[r] + p1[r]; }
            l = l * alpha + ls;
            if (resc) {
                if (hi == 0) wsf[r32] = alpha;
#pragma unroll
                for (int r = 0; r < 16; ++r) { const float a = wsf[crow(r, hi)]; o0[r] *= a; o1[r] *= a; }
            }
            u32x4 pw[4];
#pragma unroll
            for (int j = 0; j < 4; ++j) { pw[0][j] = cvtpk(p0[2 * j], p0[2 * j + 1]); pw[1][j] = cvtpk(p0[8 + 2 * j], p0[8 + 2 * j + 1]);
                                          pw[2][j] = cvtpk(p1[2 * j], p1[2 * j + 1]); pw[3][j] = cvtpk(p1[8 + 2 * j], p1[8 + 2 * j + 1]); }
            const LAS char* vp = (const LAS char*)Vs + ((lane >> 4) & 1) * 32 + (lane & 3) * 8 + (4 * hi + ((lane & 15) >> 2)) * 64;
#pragma unroll
            for (int ks = 0; ks < 4; ++ks) {
                const s16x4 a0 = vtr(vp + ks * 1024), a1 = vtr(vp + ks * 1024 + 512), c0 = vtr(vp + 4096 + ks * 1024), c1 = vtr(vp + 4096 + ks * 1024 + 512);
                const bf16x8 vf0 = {a0[0], a0[1], a0[2], a0[3], a1[0], a1[1], a1[2], a1[3]}, vf1 = {c0[0], c0[1], c0[2], c0[3], c1[0], c1[1], c1[2], c1[3]};
                const bf16x8 pa = __builtin_bit_cast(bf16x8, pw[ks]);
                o0 = __builtin_amdgcn_mfma_f32_32x32x16_bf16(pa, vf0, o0, 0, 0, 0);
                o1 = __builtin_amdgcn_mfma_f32_32x32x16_bf16(pa, vf1, o1, 0, 0, 0);
            }
        }
        __syncthreads();
    }
    l += __shfl_xor(l, 32);
    if (hi == 0) { wsf[r32] = 1.0f / l; wsf[32 + r32] = m + __builtin_amdgcn_logf(l); }
    LAS bf16_t* stg = (LAS bf16_t*)ost;
#pragma unroll
    for (int r = 0; r < 16; ++r) { const float il = wsf[crow(r, hi)]; const int orow = crow(r, hi);
        stg[orow * 64 + r32] = (bf16_t)(cvtpk(o0[r] * il, 0.f) & 0xffffu); stg[orow * 64 + 32 + r32] = (bf16_t)(cvtpk(o1[r] * il, 0.f) & 0xffffu); }
    asm volatile("s_waitcnt lgkmcnt(0)" ::: "memory");
#pragma unroll
    for (int i = 0; i < 4; ++i) {
        const int row = i * 8 + (lane >> 3), ch = lane & 7;
        u32x4 vnew = *(const LAS u32x4*)(stg + row * 64 + ch * 8);
        const size_t grow = (size_t)(S.row0 + (qsw + row) * S.rstep);
        bf16_t* op = S.o + grow * S.ldo + ch * 8;
        if (MODE == MODE_DIL) {
            const float ln = wsf[32 + row]; float* lp = S.lse + grow * 16 + S.head;
            if (S.merge) {
                const float lo = *lp; const u32x4 vold = *(const u32x4*)op;
                const float mx = fmaxf(lo, ln), wo = __builtin_amdgcn_exp2f(lo - mx), wn = __builtin_amdgcn_exp2f(ln - mx), inv = 1.0f / (wo + wn), a = wo * inv, c = wn * inv;
                u32x4 res;
#pragma unroll
                for (int e = 0; e < 4; ++e) res[e] = cvtpk(a * bf_lo(vold[e]) + c * bf_lo(vnew[e]), a * bf_hi(vold[e]) + c * bf_hi(vnew[e]));
                vnew = res;
                if (ch == 0) *lp = mx + __builtin_amdgcn_logf(wo + wn);
            } else if (ch == 0) *lp = ln;
        }
        *(u32x4*)op = vnew;
    }
    __syncthreads();
}
}
namespace cg = cooperative_groups;
constexpr int NTHREADS = 512, NWAVES = 8;
constexpr int N_PHASES = 39;

struct Ctx {
    LAS unsigned char* lds; int tid, lane, wave, vcu, G, gw, ngw;
    const __attribute__((address_space(4))) void* ka; float* H; unsigned char* ws; int bx;
};
__device__ __forceinline__ const float* INP(const Ctx& C, int i) { return ((const float* const __attribute__((address_space(4)))*)C.ka)[i]; }
__device__ __forceinline__ Ctx make_ctx(LAS unsigned char* lds) {
    Ctx C; C.lds = lds; int tid = threadIdx.x; asm volatile("" : "+v"(tid)); C.tid = tid; C.lane = tid & 63; C.wave = __builtin_amdgcn_readfirstlane(tid >> 6);
    int G = gridDim.x, bx = blockIdx.x; asm volatile("" : "+s"(G), "+s"(bx)); C.G = G; C.bx = bx; C.vcu = (G % 8 == 0) ? (bx % 8) * (G / 8) + bx / 8 : bx;
    C.gw = C.vcu * NWAVES + C.wave; C.ngw = G * NWAVES;
    const __attribute__((address_space(4))) void* ka = (const __attribute__((address_space(4))) void*)__builtin_amdgcn_kernarg_segment_ptr(); asm volatile("" : "+s"(ka)); C.ka = ka;
    C.H = ((const __attribute__((address_space(4))) Args*)ka)->out; C.ws = ((const __attribute__((address_space(4))) Args*)ka)->ws; return C;
}
__device__ __forceinline__ u64* ss_arr(const Ctx& C, int idx) { return (u64*)(C.ws + WS_SS) + (size_t)idx * MTOK; }

__device__ __forceinline__ void cvt_mixer(const Ctx& C, int layer) {
    LAS float* scr = (LAS float*)(C.lds + C.wave * 16384);
    const int mixer = layer % 3, j = layer / 3; const float* g0 = INP(C, 3) + (size_t)layer * 4096;
    bf16_t* wmix = (bf16_t*)(C.ws + WS_WMIX); bf16_t* wo = (bf16_t*)(C.ws + WS_WO);
    if (mixer == 0) {
        cvt_run(CvtJob{INP(C, 9) + (size_t)j * 1024 * 672, wmix, g0, 1024, 672, 768, 0}, scr, C.gw, C.ngw, C.lane);
        cvt_run(CvtJob{INP(C, 12) + (size_t)j * 384 * 1536, (bf16_t*)(C.ws + WS_WMIX + 2 * MiB), INP(C, 10) + j * 384, 384, 1536, 1536, 0}, scr, C.gw, C.ngw, C.lane);
        cvt_run(CvtJob{INP(C, 13) + (size_t)j * 256 * 2048, (bf16_t*)(C.ws + WS_WMIX + 4 * MiB), INP(C, 11) + j * 256, 256, 2048, 2048, 0}, scr, C.gw, C.ngw, C.lane);
        cvt_run(CvtJob{INP(C, 14) + (size_t)j * 1024 * 1024, wo, nullptr, 1024, 1024, 1024, 0}, scr, C.gw, C.ngw, C.lane);
    } else if (mixer == 1) {
        cvt_run(CvtJob{INP(C, 15) + (size_t)j * 1024 * 9216, wmix, g0, 1024, 9216, 9216, 0}, scr, C.gw, C.ngw, C.lane);
        cvt_run(CvtJob{INP(C, 16) + (size_t)j * 1024 * 1024, wo, nullptr, 1024, 1024, 1024, 0}, scr, C.gw, C.ngw, C.lane);
    } else {
        cvt_run(CvtJob{INP(C, 17) + (size_t)j * 1024 * 3088, wmix, g0, 1024, 3088, 3328, 0}, scr, C.gw, C.ngw, C.lane);
        cvt_run(CvtJob{INP(C, 19) + (size_t)j * 1024 * 1024, wo, nullptr, 1024, 1024, 1024, 0}, scr, C.gw, C.ngw, C.lane);
    }
}
__device__ __forceinline__ void cvt_ffn(const Ctx& C, int layer) {
    LAS float* scr = (LAS float*)(C.lds + C.wave * 16384);
    cvt_run(CvtJob{INP(C, 4) + (size_t)layer * 1024 * 5632, (bf16_t*)(C.ws + WS_WIN), nullptr, 1024, 5632, 5632, 1}, scr, C.gw, C.ngw, C.lane);
    cvt_run(CvtJob{INP(C, 5) + (size_t)layer * 2816 * 1024, (bf16_t*)(C.ws + WS_WOUT), nullptr, 2816, 1024, 1024, 0}, scr, C.gw, C.ngw, C.lane);
}
__device__ __forceinline__ void cvt_ple(const Ctx& C, int layer) {
    LAS float* scr = (LAS float*)(C.lds + C.wave * 16384);
    cvt_run(CvtJob{INP(C, 6) + (size_t)layer * 256 * 1024, (bf16_t*)(C.ws + WS_WPROJ), nullptr, 256, 1024, 1024, 0}, scr, C.gw, C.ngw, C.lane);
    cvt_run(CvtJob{INP(C, 7) + (size_t)layer * 1024 * 1024, (bf16_t*)(C.ws + WS_WGATE), nullptr, 1024, 1024, 1024, 0}, scr, C.gw, C.ngw, C.lane);
}

__device__ __forceinline__ int t5_bucket(int dist) {
    if (dist < 16) return dist;
    const float n = (float)dist;
    int large = 16 + (int)(logf(n / 16.0f) / 4.852030263919617f * 16.0f);
    return large < 31 ? large : 31;
}

struct Row16 { f32x4 a[4]; };
__device__ __forceinline__ Row16 ld_row_f32(const float* p, int lane) { Row16 r; const f32x4* q = (const f32x4*)(p + 8 * lane); r.a[0] = q[0]; r.a[1] = q[1]; q = (const f32x4*)(p + 512 + 8 * lane); r.a[2] = q[0]; r.a[3] = q[1]; return r; }
__device__ __forceinline__ void st_row_f32(float* p, int lane, const Row16& r) { f32x4* q = (f32x4*)(p + 8 * lane); q[0] = r.a[0]; q[1] = r.a[1]; q = (f32x4*)(p + 512 + 8 * lane); q[0] = r.a[2]; q[1] = r.a[3]; }
__device__ __forceinline__ Row16 ld_row_bf16(const bf16_t* p, int lane) { Row16 r; const u32x4 w0 = *(const u32x4*)(p + 8 * lane), w1 = *(const u32x4*)(p + 512 + 8 * lane);
    r.a[0] = (f32x4){bf_lo(w0.x), bf_hi(w0.x), bf_lo(w0.y), bf_hi(w0.y)}; r.a[1] = (f32x4){bf_lo(w0.z), bf_hi(w0.z), bf_lo(w0.w), bf_hi(w0.w)};
    r.a[2] = (f32x4){bf_lo(w1.x), bf_hi(w1.x), bf_lo(w1.y), bf_hi(w1.y)}; r.a[3] = (f32x4){bf_lo(w1.z), bf_hi(w1.z), bf_lo(w1.w), bf_hi(w1.w)}; return r; }
__device__ __forceinline__ void st_row_bf16(bf16_t* p, int lane, const Row16& r) { *(u32x4*)(p + 8 * lane) = pg8::pack8(r.a[0], r.a[1]); *(u32x4*)(p + 512 + 8 * lane) = pg8::pack8(r.a[2], r.a[3]); }
__device__ __forceinline__ float row_ss(const Row16& r) { return wave_sum((pg8::sq4(r.a[0]) + pg8::sq4(r.a[1])) + (pg8::sq4(r.a[2]) + pg8::sq4(r.a[3]))); }

__device__ __forceinline__ void ph_prologue(const Ctx& C) {
    { u32x4* z = (u32x4*)(C.ws + WS_SS); for (int i = C.gw * 64 + C.lane; i < (int)(2 * MiB / 16); i += C.ngw * 64) z[i] = (u32x4){0u, 0u, 0u, 0u}; }
    cvt_mixer(C, 0); cvt_ffn(C, 0); cvt_ple(C, 0);
    { float* rc = (float*)(C.ws + WS_ROPE); const int* pos = (const int*)INP(C, 2);
      for (int i = C.gw * 64 + C.lane; i < MTOK * 16; i += C.ngw * 64) { const int row = i >> 4, f = i & 15;
          const float inv = powf(10000.0f, -(float)f / 16.0f); const float ang = (float)pos[row] * inv;
          const double ad = (double)ang, twopi = 6.283185307179586476925; const float r = (float)(ad - rint(ad / twopi) * twopi);
          rc[i] = cosf(r); rc[MTOK * 16 + i] = sinf(r); } }
    { float* bt = (float*)(C.ws + WS_BIAS); const float* rb = INP(C, 8);
      for (int i = C.gw * 64 + C.lane; i < 3 * 16 * 132; i += C.ngw * 64) { const int g = i / (16 * 132), h = (i / 132) % 16, rel = i % 132; const int d = (g == 0) ? 1 : (g == 1) ? 4 : 16;
          bt[i] = (rel <= 128) ? rb[t5_bucket(rel * d) * 48 + g * 16 + h] * LOG2E : 0.f; } }
    { const float* x = INP(C, 0); bf16_t* xn1 = (bf16_t*)(C.ws + WS_XN1); u64* ss = ss_arr(C, SS_IN + 0);
      for (int row = C.gw; row < MTOK; row += C.ngw) { const Row16 r = ld_row_f32(x + (size_t)row * 1024, C.lane);
          st_row_f32(C.H + (size_t)row * 1024, C.lane, r); st_row_bf16(xn1 + (size_t)row * 1024, C.lane, r);
          const float s = row_ss(r); if (C.lane == 0) ss[row] = (u64)(s * SS_SCALE + 0.5f); } }
}
__device__ __forceinline__ void ph_r1(const Ctx& C, int layer) {
    const bf16_t* y = (const bf16_t*)(C.ws + WS_BIG + BIG_Y); bf16_t* xn0 = (bf16_t*)(C.ws + WS_XN0); const u64* ssy = ss_arr(C, SS_Y1 + layer);
    const float* g1 = INP(C, 3) + (size_t)layer * 4096 + 1024; const float* g2 = g1 + 1024;
    const Row16 G1 = ld_row_f32(g1, C.lane), G2 = ld_row_f32(g2, C.lane);
    for (int row = C.gw; row < MTOK; row += C.ngw) {
        Row16 h = ld_row_f32(C.H + (size_t)row * 1024, C.lane); const Row16 yv = ld_row_bf16(y + (size_t)row * 1024, C.lane);
        const float rs = 1.0f / sqrtf(ss_get(ssy + row) * (1.0f / 1024.0f) + NEPS);
#pragma unroll
        for (int i = 0; i < 4; ++i) h.a[i] += yv.a[i] * rs * G1.a[i];
        st_row_f32(C.H + (size_t)row * 1024, C.lane, h);
        const float rs2 = 1.0f / sqrtf(row_ss(h) * (1.0f / 1024.0f) + NEPS);
#pragma unroll
        for (int i = 0; i < 4; ++i) h.a[i] = h.a[i] * rs2 * G2.a[i];
        st_row_bf16(xn0 + (size_t)row * 1024, C.lane, h);
    }
    if (layer + 1 < 4) cvt_mixer(C, layer + 1);
    if (layer > 0) cvt_ple(C, layer);
}
__device__ __forceinline__ void ph_r2(const Ctx& C, int layer) {
    const bf16_t* y = (const bf16_t*)(C.ws + WS_BIG + BIG_Y2); bf16_t* xn0 = (bf16_t*)(C.ws + WS_XN0); const u64* ssy = ss_arr(C, SS_Y2 + layer);
    const float* g3 = INP(C, 3) + (size_t)layer * 4096 + 3072; const Row16 G3 = ld_row_f32(g3, C.lane);
    const float* p = INP(C, 1) + (size_t)layer * MTOK * 256; bf16_t* pbf = (bf16_t*)(C.ws + WS_BIG + BIG_PBF);
    for (int row = C.gw; row < MTOK; row += C.ngw) {
        Row16 h = ld_row_f32(C.H + (size_t)row * 1024, C.lane); const Row16 yv = ld_row_bf16(y + (size_t)row * 1024, C.lane);
        const float rs = 1.0f / sqrtf(ss_get(ssy + row) * (1.0f / 1024.0f) + NEPS);
#pragma unroll
        for (int i = 0; i < 4; ++i) h.a[i] += yv.a[i] * rs * G3.a[i];
        st_row_f32(C.H + (size_t)row * 1024, C.lane, h); st_row_bf16(xn0 + (size_t)row * 1024, C.lane, h);
        const f32x4 pv = *(const f32x4*)(p + (size_t)row * 256 + 4 * C.lane);
        *(u32x2*)(pbf + (size_t)row * 256 + 4 * C.lane) = pg8::pack4(pv);
    }
    if (layer + 1 < 4) cvt_ffn(C, layer + 1);
}
template <class Epi> __device__ __forceinline__ void run_gemm(const Ctx& C, const bf16_t* A, int lda, const bf16_t* Bt, int ldb, int N, int K, const Epi& E) {
    pg8::Gemm g{A, Bt, lda, ldb, MTOK, N, K}; pg8::StaticOrder S; S.init(MTOK, N, C.G, C.bx);
    pg8::gemm_phase<Epi, true, true>(C.lds, g, S, E, C.tid);
}
template <int DK, int MODE> __device__ __forceinline__ void ph_attn_causal(const Ctx& C) {
    const int bh = C.vcu >> 1, b = bh >> 4, h = bh & 15, s = C.vcu & 1;
    if (MODE == att::MODE_FOX) {
        LAS float* tab = (LAS float*)(C.lds + att::L_TAB); LAS float* wt = (LAS float*)(C.lds + att::L_WSF);
        const float* lf = (const float*)(C.ws + WS_LF) + (size_t)b * SEQL * 16 + h;
        float c[4]; float run = 0.f;
#pragma unroll
        for (int e = 0; e < 4; ++e) { run += lf[(size_t)(4 * C.tid + e) * 16]; c[e] = run; }
        float sc = run;
#pragma unroll
        for (int o = 1; o < 64; o <<= 1) { const float v = __shfl_up(sc, o); if (C.lane >= o) sc += v; }
        if (C.lane == 63) wt[C.wave] = sc;
        __syncthreads();
        float base = sc - run;
        for (int w = 0; w < C.wave; ++w) base += wt[w];
#pragma unroll
        for (int e = 0; e < 4; ++e) tab[4 * C.tid + e] = -(base + c[e]) * LOG2E;
        __syncthreads();
    }
    for (int i = 0; i < 4; ++i) {
        const int qb = (i == 0) ? 7 - s : (i == 1) ? s : (i == 2) ? 5 - s : 2 + s;
        att::Stream S;
        if (DK == 96) { S.q = (const bf16_t*)(C.ws + WS_BIG + BIG_Q) + h * 96; S.ldq = 1536; S.k = (const bf16_t*)(C.ws + WS_BIG + BIG_KN) + h * 64; S.v = (const bf16_t*)(C.ws + WS_BIG + BIG_V) + h * 64; S.kr = (const bf16_t*)(C.ws + WS_KR); }
        else { S.q = (const bf16_t*)(C.ws + WS_BIG + BIG_FQ) + h * 64; S.ldq = 1024; S.k = (const bf16_t*)(C.ws + WS_BIG + BIG_FK) + h * 64; S.v = (const bf16_t*)(C.ws + WS_BIG + BIG_FV) + h * 64; S.kr = nullptr; }
        S.ldk = 1024; S.ldv = 1024; S.o = (bf16_t*)(C.ws + WS_BIG + BIG_O) + h * 64; S.ldo = 1024; S.lse = nullptr;
        S.row0 = b * SEQL; S.rstep = 1; S.qs0 = 256 * qb; S.kt0 = 0; S.nt = 4 * (qb + 1); S.head = h; S.merge = 0;
        att::run_unit<8, DK, MODE>(C.lds, S, C.wave, C.lane);
    }
}
__device__ __forceinline__ void ph_attn_dil(const Ctx& C, int g) {
    const int bh = C.vcu >> 1, b = bh >> 4, h = bh & 15; const int d = (g == 0) ? 1 : (g == 1) ? 4 : 16;
    { const float* bt = (const float*)(C.ws + WS_BIAS) + (size_t)(g * 16 + h) * 132; LAS float* tab = (LAS float*)(C.lds + att::L_TAB);
      if (C.tid < 132) { const float v = bt[C.tid]; tab[C.tid] = v; tab[256 + C.tid] = v; }
      __syncthreads(); }
    const bf16_t* qkv = (const bf16_t*)(C.ws + WS_BIG + BIG_QKVG);
    for (int i = 0; i < 4; ++i) {
        const int su = 8 * C.vcu + 2 * i + (C.wave >> 2), x = su & 15;
        const int r = (d == 1) ? 0 : (d == 4) ? (x & 3) : x, n = (d == 1) ? x : (d == 4) ? (x >> 2) : 0;
        att::Stream S;
        S.q = qkv + h * 64; S.k = qkv + 1024 + h * 64; S.v = qkv + 2048 + h * 64; S.kr = nullptr; S.ldq = 3072; S.ldk = 3072; S.ldv = 3072;
        S.o = (bf16_t*)(C.ws + WS_BIG + BIG_O) + h * 64; S.ldo = 1024; S.lse = (float*)(C.ws + WS_LSE);
        S.row0 = b * SEQL + r; S.rstep = d; S.qs0 = 128 * n; S.kt0 = 128 * n - 128; S.nt = 4; S.head = h; S.merge = (g > 0);
        att::run_unit<4, 64, att::MODE_DIL>(C.lds, S, C.wave, C.lane);
    }
}
__device__ __forceinline__ void ph_common(const Ctx& C, int layer, int st) {
    unsigned char* big = C.ws + WS_BIG;
    switch (st) {
    case 0: run_gemm(C, (const bf16_t*)(big + BIG_O), 1024, (const bf16_t*)(C.ws + WS_WO), 1024, 1024, 1024, pg8::EpiY<true>{(bf16_t*)(big + BIG_Y), ss_arr(C, SS_Y1 + layer)}); break;
    case 1: ph_r1(C, layer); break;
    case 2: run_gemm(C, (const bf16_t*)(C.ws + WS_XN0), 1024, (const bf16_t*)(C.ws + WS_WIN), 1024, 5632, 1024, pg8::EpiSwiglu{(bf16_t*)(big + BIG_ACT)}); break;
    case 3: run_gemm(C, (const bf16_t*)(big + BIG_ACT), DFF, (const bf16_t*)(C.ws + WS_WOUT), DFF, 1024, DFF, pg8::EpiY<true>{(bf16_t*)(big + BIG_Y2), ss_arr(C, SS_Y2 + layer)}); break;
    case 4: ph_r2(C, layer); break;
    default: {
        run_gemm(C, (const bf16_t*)(big + BIG_PBF), 256, (const bf16_t*)(C.ws + WS_WPROJ), 256, 1024, 256, pg8::EpiY<false>{(bf16_t*)(big + BIG_PP), nullptr});
        asm volatile("s_waitcnt vmcnt(0)" ::: "memory"); __builtin_amdgcn_fence(__ATOMIC_RELEASE, "agent"); asm volatile("s_waitcnt vmcnt(0)" ::: "memory");
        __syncthreads(); __builtin_amdgcn_fence(__ATOMIC_ACQUIRE, "agent"); asm volatile("s_waitcnt vmcnt(0)" ::: "memory"); __syncthreads();
        const bool lastl = (layer == 3); const Ctx C2 = make_ctx(C.lds);
        run_gemm(C2, (const bf16_t*)(C2.ws + WS_XN0), 1024, (const bf16_t*)(C2.ws + WS_WGATE), 1024, 1024, 1024,
                 pg8::EpiGate{C2.H, (const bf16_t*)(C2.ws + WS_BIG + BIG_PP), lastl ? nullptr : (bf16_t*)(C2.ws + WS_XN1), lastl ? nullptr : ss_arr(C2, SS_IN + layer + 1)});
    } }
}
__device__ __forceinline__ void run_phase(const Ctx& C, int ph) {
    if (ph == 0) { ph_prologue(C); return; }
    int layer, st;
    if (ph < 10) { layer = 0; st = ph - 1; } else if (ph < 22) { layer = 1; st = ph - 10; } else if (ph < 30) { layer = 2; st = ph - 22; } else { layer = 3; st = ph - 30; }
    const int mixer = layer % 3, j = layer / 3;
    unsigned char* big = C.ws + WS_BIG; const bf16_t* xn1 = (const bf16_t*)(C.ws + WS_XN1); const u64* ss_in = ss_arr(C, SS_IN + layer);
    if (mixer == 0) {
        if (st == 0) run_gemm(C, xn1, 1024, (const bf16_t*)(C.ws + WS_WMIX), 1024, 768, 1024,
                              pg8::EpiMlaA{ss_in, (bf16_t*)(big + BIG_ARAW), ss_arr(C, SS_Q + j), ss_arr(C, SS_KV + j), (bf16_t*)(C.ws + WS_KR), (const float*)(C.ws + WS_ROPE)});
        else if (st == 1) {
            run_gemm(C, (const bf16_t*)(big + BIG_ARAW), 768, (const bf16_t*)(C.ws + WS_WMIX + 2 * MiB), 384, 1536, 384, pg8::EpiMlaQ{ss_arr(C, SS_Q + j), (bf16_t*)(big + BIG_Q), (const float*)(C.ws + WS_ROPE)});
            const Ctx C2 = make_ctx(C.lds);
            run_gemm(C2, (const bf16_t*)(C2.ws + WS_BIG + BIG_ARAW) + 384, 768, (const bf16_t*)(C2.ws + WS_WMIX + 4 * MiB), 256, 2048, 256, pg8::EpiMlaKV{ss_arr(C2, SS_KV + j), (bf16_t*)(C2.ws + WS_BIG + BIG_KN), (bf16_t*)(C2.ws + WS_BIG + BIG_V)});
        } else if (st == 2) ph_attn_causal<96, att::MODE_CAUSAL>(C);
        else ph_common(C, layer, st - 3);
    } else if (mixer == 1) {
        if (st < 6) { const int g = st >> 1;
            if ((st & 1) == 0) { bf16_t* qkv = (bf16_t*)(big + BIG_QKVG);
                run_gemm(C, xn1, 1024, (const bf16_t*)(C.ws + WS_WMIX) + (size_t)g * 3072 * 1024, 1024, 3072, 1024, pg8::EpiQKV{ss_in, qkv, (size_t)1024, 3072, nullptr, nullptr});
            } else ph_attn_dil(C, g);
        } else ph_common(C, layer, st - 6);
    } else {
        if (st == 0) run_gemm(C, xn1, 1024, (const bf16_t*)(C.ws + WS_WMIX), 1024, 3328, 1024,
                              pg8::EpiQKV{ss_in, (bf16_t*)(big + BIG_FQ), (size_t)(BIG_FK - BIG_FQ) / 2, 1024, (float*)(C.ws + WS_LF), INP(C, 18) + j * 16});
        else if (st == 1) ph_attn_causal<64, att::MODE_FOX>(C);
        else ph_common(C, layer, st - 2);
    }
}


#define XB_TMO      128
#define XB_XCNT(j)  (256  + 64 * (j))
#define XB_XSUB(j)  (1280 + 64 * (j))
#define XB_XGEN(j)  (2304 + 64 * (j))
#define XB_TOP      3328
#define XB_TOPGEN   3392
#define XCD_BAR_WORDS 3456
#define XB_SPIN_CAP (1u << 22)
__device__ __forceinline__ unsigned xb_ld(unsigned* p)              { return __hip_atomic_load(p, __ATOMIC_RELAXED, __HIP_MEMORY_SCOPE_AGENT); }
__device__ __forceinline__ unsigned xb_add(unsigned* p, unsigned v) { return __hip_atomic_fetch_add(p, v, __ATOMIC_RELAXED, __HIP_MEMORY_SCOPE_AGENT); }
__device__ __forceinline__ unsigned xb_xcc_id() { return (unsigned)__builtin_amdgcn_s_getreg((3 << 11) | 20) & 0xFu; }
#define XB_SPIN(cond, bar) do { unsigned _sp = 0; while (cond) { __builtin_amdgcn_s_sleep(1); \
    if ((++_sp & 255u) == 0u) { if (xb_ld(&(bar)[XB_TMO])) break; if (_sp > XB_SPIN_CAP) { atomicAdd(&(bar)[XB_TMO], 1u); break; } } } } while (0)
struct XcdBarrier { unsigned* bar; unsigned x; volatile LAS unsigned* st; };
__device__ __forceinline__ XcdBarrier xcd_barrier_post(unsigned* bar, volatile LAS unsigned* st) {
    XcdBarrier b; b.bar = bar; b.x = xb_xcc_id(); b.st = st;
    if (threadIdx.x == 0) (void)xb_add(&bar[XB_XCNT(b.x)], 1u);
    return b;
}
__device__ __forceinline__ void xcd_barrier_complete(unsigned* bar, unsigned x, unsigned& nloc, unsigned& nx) {
    const unsigned G = gridDim.x * gridDim.y * gridDim.z;
    unsigned sum, cnt, mine, sp = 0u;
    for (;;) {
        sum = 0u; cnt = 0u; mine = 0u;
#pragma unroll
        for (unsigned j = 0; j < 16; ++j) { const unsigned c = xb_ld(&bar[XB_XCNT(j)]); sum += c; cnt += (c > 0u) ? 1u : 0u; mine = (j == x) ? c : mine; }
        if (sum == G) break;
        __builtin_amdgcn_s_sleep(1);
        if ((++sp & 255u) == 0u) { if (xb_ld(&bar[XB_TMO])) break; if (sp > XB_SPIN_CAP) { atomicAdd(&bar[XB_TMO], 1u); break; } }
    }
    nloc = mine > 0u ? mine : 1u; nx = cnt > 0u ? cnt : 1u;
}
__device__ __forceinline__ void xcd_barrier(const XcdBarrier& b) {
    asm volatile("s_waitcnt vmcnt(0)" ::: "memory");
    __syncthreads();
    if (threadIdx.x == 0) {
        unsigned* bar = b.bar;
        __builtin_amdgcn_s_waitcnt(0);
        unsigned nloc = b.st[0], nx = b.st[1];
        if (nloc == 0u) { xcd_barrier_complete(bar, b.x, nloc, nx); b.st[0] = nloc; b.st[1] = nx; }
        const unsigned old = xb_add(&bar[XB_XSUB(b.x)], 1u);
        const unsigned gen = old / nloc;
        if (old + 1u == (gen + 1u) * nloc) {
            __builtin_amdgcn_fence(__ATOMIC_RELEASE, "agent");
            asm volatile("s_waitcnt vmcnt(0)" ::: "memory");
            const unsigned og = xb_add(&bar[XB_TOP], 1u);
            const unsigned tg = og / nx;
            if (og + 1u == (tg + 1u) * nx) xb_add(&bar[XB_TOPGEN], 1u);
            else XB_SPIN(xb_ld(&bar[XB_TOPGEN]) == tg, bar);
            __builtin_amdgcn_fence(__ATOMIC_ACQUIRE, "agent");
            xb_add(&bar[XB_XGEN(b.x)], 1u);
            asm volatile("s_waitcnt vmcnt(0)" ::: "memory");
        } else {
            XB_SPIN(xb_ld(&bar[XB_XGEN(b.x)]) == gen, bar);
            __builtin_amdgcn_fence(__ATOMIC_ACQUIRE, "agent");
            asm volatile("s_waitcnt vmcnt(0)" ::: "memory");
        }
    }
    __syncthreads();
}

__global__ void __launch_bounds__(NTHREADS, 2) mega_fwd(Args args) {
    extern __shared__ __attribute__((aligned(16))) unsigned char lds_raw[];
    volatile LAS unsigned* misc = (volatile LAS unsigned*)((LAS unsigned char*)lds_raw + RING_BYTES);
    if (threadIdx.x < 64) misc[threadIdx.x] = 0u;
    __syncthreads();
    XcdBarrier bar; bar.bar = (unsigned*)(args.ws + WS_CTL) + 64; bar.x = 0; bar.st = misc + 8;
    if (args.ph_hi - args.ph_lo > 1) bar = xcd_barrier_post((unsigned*)(args.ws + WS_CTL) + 64, misc + 8);
    for (int ph = args.ph_lo; ph < args.ph_hi; ++ph) {
        { const Ctx C = make_ctx((LAS unsigned char*)lds_raw); run_phase(C, ph); }
        if (ph + 1 < args.ph_hi) { if (ph == args.ph_lo) cg::this_grid().sync(); else xcd_barrier(bar); }
    }
}
#ifndef MK_MODE
#define MK_MODE 0
#endif
#if MK_MODE == 2
__global__ void dbg_compare(const float* a, const float* ref, int n, unsigned* flag, int stage, float tol2) {
    __shared__ float s1[1024], s2[1024];
    float e = 0.f, r = 0.f; bool bad = false;
    for (int i = threadIdx.x; i < n; i += 1024) { const float d = a[i] - ref[i]; e += d * d; r += ref[i] * ref[i]; if (!(fabsf(a[i]) < 1e30f)) bad = true; }
    s1[threadIdx.x] = bad ? 1e30f : e; s2[threadIdx.x] = r; __syncthreads();
    for (int o = 512; o > 0; o >>= 1) { if ((int)threadIdx.x < o) { s1[threadIdx.x] += s1[threadIdx.x + o]; s2[threadIdx.x] += s2[threadIdx.x + o]; } __syncthreads(); }
    if (threadIdx.x == 0) { if (!(s1[0] <= tol2 * s2[0])) atomicMin(flag, (unsigned)stage); }
}
__global__ void dbg_final(float* out, int n, const unsigned* flag) {
    const unsigned f = *flag; if (f == 0xffffffffu) return;
    for (int i = blockIdx.x * blockDim.x + threadIdx.x; i < n; i += gridDim.x * blockDim.x) out[i] = (i == 0) ? 1000.0f * (float)(f + 1) : 0.f;
}
#endif
extern "C" void kernel_launch(void* const* d_in, const int* in_sizes, int n_in, void* d_out, int out_size, void* d_ws, size_t ws_size, hipStream_t stream) {
    static int grid = 0;
    if (grid == 0) {
        int dev = 0, cus = 0, per_cu = 0;
        if (n_in != 20 || out_size != MTOK * DMODEL || ws_size < WS_END + (MK_MODE == 2 ? 64 * MiB : 0)) { fprintf(stderr, "kernel_launch: unexpected problem geometry (n_in %d out %d ws %zu)\n", n_in, out_size, ws_size); grid = -1; return; }
        (void)hipGetDevice(&dev); (void)hipDeviceGetAttribute(&cus, hipDeviceAttributeMultiprocessorCount, dev);
        if (hipFuncSetAttribute((const void*)mega_fwd, hipFuncAttributeMaxDynamicSharedMemorySize, LDS_BYTES) != hipSuccess) { fprintf(stderr, "kernel_launch: hipFuncSetAttribute failed\n"); grid = -1; return; }
        if (hipOccupancyMaxActiveBlocksPerMultiprocessor(&per_cu, (const void*)mega_fwd, NTHREADS, LDS_BYTES) != hipSuccess || per_cu < 1) { fprintf(stderr, "kernel_launch: occupancy query says %d blocks per CU\n", per_cu); grid = -1; (void)hipGetLastError(); return; }
        grid = cus;
        if (grid != 256) { fprintf(stderr, "kernel_launch: built for a 256-CU device, found %d CUs\n", cus); grid = -1; return; }
    }
    if (grid < 0) return;
    Args a{};
    for (int i = 0; i < 20; ++i) a.in[i] = (const float*)d_in[i];
    a.out = (float*)d_out; a.ws = (unsigned char*)d_ws;
#if MK_MODE == 0
    a.ph_lo = 0; a.ph_hi = N_PHASES;
    (void)hipMemsetAsync((char*)d_ws + WS_CTL, 0, 65536, stream);
    void* kargs[] = {&a};
    hipError_t e = hipLaunchCooperativeKernel((const void*)mega_fwd, dim3(grid), dim3(NTHREADS), kargs, LDS_BYTES, stream);
    if (e != hipSuccess) fprintf(stderr, "kernel_launch: cooperative launch failed: %s\n", hipGetErrorString(e));
#else
#if MK_MODE == 2
    unsigned char* ws = (unsigned char*)d_ws;
    float* ck = (float*)(ws + WS_END);
    unsigned* flag = (unsigned*)(ws + WS_CTL);
    (void)hipMemsetAsync(flag, 0xff, 4, stream);
    const size_t CKB = (size_t)SEQL * DMODEL * 4;
#endif
#ifndef PH_LIMIT
#define PH_LIMIT N_PHASES
#endif
    for (int ph = 0; ph < PH_LIMIT; ++ph) {
        a.ph_lo = ph; a.ph_hi = ph + 1;
        hipLaunchKernelGGL(mega_fwd, dim3(grid), dim3(NTHREADS), LDS_BYTES, stream, a);
#if MK_MODE == 2
        int k = -1;
        if (ph == 5) k = 0; else if (ph == 9) k = 1; else if (ph == 17) k = 2; else if (ph == 21) k = 3; else if (ph == 25) k = 4; else if (ph == 29) k = 5; else if (ph == 34) k = 6; else if (ph == 38) k = 7;
        if (k >= 0) (void)hipMemcpyAsync((char*)ck + k * CKB, d_out, CKB, hipMemcpyDeviceToDevice, stream);
#endif
    }
#if MK_MODE == 2
    nv::In I;
    I.x = (const float*)d_in[0]; I.p = (const float*)d_in[1]; I.pos = (const int*)d_in[2]; I.norm_g = (const float*)d_in[3];
    I.ffn_in = (const float*)d_in[4]; I.ffn_out = (const float*)d_in[5]; I.ple_proj = (const float*)d_in[6]; I.ple_gate = (const float*)d_in[7];
    I.rel_bias = (const float*)d_in[8]; I.mla_a = (const float*)d_in[9]; I.mla_qn = (const float*)d_in[10]; I.mla_kvn = (const float*)d_in[11];
    I.mla_uq = (const float*)d_in[12]; I.mla_ukv = (const float*)d_in[13]; I.mla_o = (const float*)d_in[14]; I.dil_qkv = (const float*)d_in[15];
    I.dil_o = (const float*)d_in[16]; I.fox_qkvf = (const float*)d_in[17]; I.fox_bf = (const float*)d_in[18]; I.fox_o = (const float*)d_in[19];
    float* nvh = (float*)(ws + WS_XN0);
    float* scr = (float*)(ws + WS_BIG);
    for (int i = 0; i < 4; ++i) {
        (void)hipMemcpyAsync(nvh, i == 0 ? (const void*)I.x : (const void*)((char*)ck + (2 * (i - 1) + 1) * CKB), CKB, hipMemcpyDeviceToDevice, stream);
        nv::dbg_mid = (float*)((char*)ck + (2 * i) * CKB); nv::dbg_flag = flag; nv::dbg_stage = 2 * i;
        nv::run_batch(stream, I, 0, nvh, scr, i, i + 1);
        hipLaunchKernelGGL(dbg_compare, dim3(1), dim3(1024), 0, stream, (const float*)((char*)ck + (2 * i + 1) * CKB), (const float*)nvh, SEQL * DMODEL, flag, 2 * i + 1, DBG_TOL2);
    }
    hipLaunchKernelGGL(dbg_final, dim3(1024), dim3(256), 0, stream, (float*)d_out, MTOK * DMODEL, (const unsigned*)flag);
#endif
#endif
}
```

```cpp
#include <hip/hip_runtime.h>
#include <hip/hip_cooperative_groups.h>
#include <cstdio>
#include <cstdint>
#include <cmath>
#define MK_MODE 0
#define LAS __attribute__((address_space(3)))
#define GAS __attribute__((address_space(1)))
typedef unsigned short bf16_t;
typedef short bf16x8 __attribute__((ext_vector_type(8)));
typedef short s16x4 __attribute__((ext_vector_type(4)));
typedef float f32x2 __attribute__((ext_vector_type(2)));
typedef float f32x4 __attribute__((ext_vector_type(4)));
typedef float f32x16 __attribute__((ext_vector_type(16)));
typedef unsigned u32x2 __attribute__((ext_vector_type(2)));
typedef unsigned u32x4 __attribute__((ext_vector_type(4)));
typedef __bf16 bf16x2_t __attribute__((ext_vector_type(2)));

constexpr int MTOK = 16384, DMODEL = 1024, SEQL = 2048, NBATCH = 8, DFF = 2816;
constexpr float NEPS = 1e-6f;
constexpr float LOG2E = 1.4426950408889634f;
constexpr float C2_64 = 0.125f * LOG2E;
constexpr float C2_96 = 0.10206207261596575f * LOG2E;

__device__ __forceinline__ unsigned cvtpk(float lo, float hi) { f32x2 v = {lo, hi}; bf16x2_t b = __builtin_convertvector(v, bf16x2_t); return __builtin_bit_cast(unsigned, b); }
__device__ __forceinline__ float bf_lo(unsigned u) { return __uint_as_float(u << 16); }
__device__ __forceinline__ float bf_hi(unsigned u) { return __uint_as_float(u & 0xffff0000u); }
__device__ __forceinline__ float wave_sum(float v) {
#pragma unroll
    for (int o = 1; o < 64; o <<= 1) v += __shfl_xor(v, o);
    return v;
}
typedef unsigned long long u64;
constexpr float SS_SCALE = 16777216.0f, SS_INV = 1.0f / 16777216.0f;
__device__ __forceinline__ void ss_add(u64* p, float s) { atomicAdd(p, (u64)(s * SS_SCALE + 0.5f)); }
__device__ __forceinline__ float ss_get(const u64* p) { return (float)(*p) * SS_INV; }
__device__ __forceinline__ float sigmoidf_(float x) { return 1.0f / (1.0f + __expf(-x)); }

constexpr size_t MiB = 1u << 20;
constexpr size_t WS_CTL = 0;
constexpr size_t WS_SS = 1 * MiB;
constexpr size_t WS_ROPE = 3 * MiB;
constexpr size_t WS_BIAS = 5 * MiB;
constexpr size_t WS_LF = 6 * MiB;
constexpr size_t WS_LSE = 7 * MiB;
constexpr size_t WS_KR = 26 * MiB;
constexpr size_t WS_WMIX = 8 * MiB;
constexpr size_t WS_WO = 27 * MiB;
constexpr size_t WS_WIN = 30 * MiB;
constexpr size_t WS_WOUT = 41 * MiB;
constexpr size_t WS_WPROJ = 47 * MiB;
constexpr size_t WS_WGATE = 48 * MiB;
constexpr size_t WS_XN0 = 50 * MiB;
constexpr size_t WS_XN1 = 82 * MiB;
constexpr size_t WS_BIG = 114 * MiB;
constexpr size_t BIG_ARAW = 0, BIG_Q = 24 * MiB, BIG_KN = 72 * MiB, BIG_V = 104 * MiB;
constexpr size_t BIG_FQ = 0, BIG_FK = 32 * MiB, BIG_FV = 64 * MiB;
constexpr size_t BIG_QKVG = 0;
constexpr size_t BIG_O = 136 * MiB, BIG_Y = 24 * MiB;
constexpr size_t BIG_ACT = 0, BIG_Y2 = 96 * MiB, BIG_PP = 128 * MiB, BIG_PBF = 0;
constexpr size_t WS_END = WS_BIG + 168 * MiB;
constexpr int SS_IN = 0  , SS_Y1 = 4  , SS_Y2 = 8  , SS_Q = 12  , SS_KV = 14  ;

constexpr int RING_BYTES = 131072;
constexpr int LDS_BYTES = 147456;

struct Args { const float* in[20]; float* out; unsigned char* ws; int ph_lo, ph_hi; };

__device__ __forceinline__ int wrow_map(int n, int mode) {
    if (mode == 0) return n;
    const int up = n >= DFF, c = up ? n - DFF : n;
    return 32 * (c >> 4) + (up ? 16 : 0) + (c & 15);
}
__device__ __forceinline__ void cvt_item(const float* W, int K, int N, bf16_t* WT, const float* gv, int mode, int item, int lane) {
    const int nblk = (N + 63) / 64, kb = item / nblk, nb = item % nblk, k0 = 32 * kb, n = 64 * nb + lane;
    const bool nok = n < N; const float* src = W + (size_t)k0 * N + (nok ? n : 0);
    float v[32];
#pragma unroll
    for (int j = 0; j < 32; ++j) v[j] = src[(size_t)j * N];
    if (gv) {
#pragma unroll
        for (int j = 0; j < 32; ++j) v[j] *= gv[k0 + j];
    }
    if (nok) { bf16_t* dst = WT + (size_t)wrow_map(n, mode) * K + k0;
#pragma unroll
        for (int c = 0; c < 4; ++c) { u32x4 o; o.x = cvtpk(v[8 * c], v[8 * c + 1]); o.y = cvtpk(v[8 * c + 2], v[8 * c + 3]); o.z = cvtpk(v[8 * c + 4], v[8 * c + 5]); o.w = cvtpk(v[8 * c + 6], v[8 * c + 7]);
            *(u32x4*)(dst + 8 * c) = o; } }
}
struct CvtJob { const float* W; bf16_t* WT; const float* gv; int K, N, Npad, mode; };
__device__ __forceinline__ void cvt_run(const CvtJob& J, int gw, int ngw, int lane) {
    if (J.W == nullptr) return;
    const int nitems = (J.K / 32) * ((J.N + 63) / 64);
    for (int it = gw; it < nitems; it += ngw) cvt_item(J.W, J.K, J.N, J.WT, J.gv, J.mode, it, lane);
    const int padrows = J.Npad - J.N; const int chunks = padrows * (J.K / 8);
    for (int c = gw * 64 + lane; c < chunks; c += ngw * 64) { const int r = c / (J.K / 8), cc = c % (J.K / 8);
        *(u32x4*)(J.WT + (size_t)(J.N + r) * J.K + cc * 8) = (u32x4){0u, 0u, 0u, 0u}; }
}
namespace pg8 {
constexpr int BM = 256, BK = 64, HALF = 128, HTB = HALF * BK * 2, STAGE_BYTES = 8 * HTB, NXCD = 8, WGM = 8;
__device__ __forceinline__ int lds_byte(int r, int c) { const int st = (r >> 4) * 2 + (c >> 5), rr = r & 15, cc = c & 31, ob = rr * 64 + cc * 2; return st * 1024 + (ob ^ (((ob >> 9) & 1) << 5)); }
__device__ __forceinline__ void stage_rc(int b, int& R, int& C) { const int st = b / 1024, sb = b % 1024, swz = sb ^ (((sb >> 9) & 1) << 5); R = (st >> 1) * 16 + swz / 64; C = (st & 1) * 32 + (swz % 64) / 2; }
__device__ __forceinline__ int perm32(int rho) { const int n = rho >> 4, i = rho & 15; return 8 * (i >> 2) + 4 * n + (i & 3); }

struct Unit { int pm, pn; };
struct Gemm { const bf16_t* A; const bf16_t* Bt; int lda, ldb, M, N, K; };

struct StaticOrder {
    int nM, nN, nwg, G, c;
    __device__ void init(int M, int N, int G_, int c_) { nM = M / BM; nN = N / BM; nwg = nM * nN; G = G_; c = c_; }
    __device__ bool next(int i, Unit& u) const {
        const long L = (long)i * G + c; if (L >= nwg) return false;
        int wgid = (int)L; { const int q = nwg / NXCD, r = nwg % NXCD, xcd = wgid % NXCD, off = wgid / NXCD; wgid = (xcd < r ? xcd * (q + 1) : r * (q + 1) + (xcd - r) * q) + off; }
        const int nig = WGM * nN, gid = wgid / nig, fm = gid * WGM, gsz = (nM - fm) < WGM ? (nM - fm) : WGM;
        u.pm = fm + ((wgid % nig) % gsz); u.pn = (wgid % nig) / gsz; return true;
    }
};

typedef f32x4 Acc[2][2][4][2];

template <class Epi, bool ALIGN_EPI, bool SP2>
__device__ __forceinline__ void gemm_phase(LAS unsigned char* lds, const Gemm g, const StaticOrder& S, const Epi& E, const int tid) {
    const int wid = __builtin_amdgcn_readfirstlane(tid >> 6), lane = tid & 63, wr = wid >> 2, wc = wid & 3, fr = lane & 15, fq = lane >> 4;
    int K = g.K; asm volatile("" : "+s"(K)); const int nt = K / BK;
    unsigned voffA[2], voffB[2];
#pragma unroll
    for (int i = 0; i < 2; ++i) { int R, C; stage_rc(tid * 16 + i * 8192, R, C); const int Rb = Epi::PERM ? ((R & ~31) + perm32(R & 31)) : R;
        voffA[i] = (unsigned)(R * g.lda + C) * 2u; voffB[i] = (unsigned)(Rb * g.ldb + C) * 2u; }
    const size_t kstep = (size_t)(BK * 2);
    const size_t hstepA = (size_t)HALF * g.lda * 2, hstepB = (size_t)HALF * g.ldb * 2;
    const size_t tstepA = 2 * hstepA, tstepB = 2 * hstepB;
    const unsigned ldsw = (unsigned)wid * 1024u;
    const int aoff = lds_byte(wr * 64 + fr, fq * 8), boff = lds_byte(wc * 32 + fr, fq * 8);
#define PG8_SA(b, h) (((b) * 2 + (h)) * HTB)
#define PG8_SB(b, h) ((4 + (b) * 2 + (h)) * HTB)
#define PG8_STAGE(bufoff, gbase, voff) do { _Pragma("unroll") for (int _i = 0; _i < 2; ++_i) \
        __builtin_amdgcn_global_load_lds((const unsigned*)((const char*)(gbase) + (voff)[_i]), (LAS unsigned*)(lds + (bufoff) + ldsw + _i * 8192), 16, 0, 0); } while (0)
#define PG8_LDA(dst, b, h) do { _Pragma("unroll") for (int m = 0; m < 4; ++m) _Pragma("unroll") for (int k = 0; k < 2; ++k) dst[m][k] = *(const LAS bf16x8*)(lds + PG8_SA(b, h) + aoff + m * 2048 + k * 1024); } while (0)
#define PG8_LDB(dst, b, h) do { _Pragma("unroll") for (int n = 0; n < 2; ++n) _Pragma("unroll") for (int k = 0; k < 2; ++k) dst[n][k] = *(const LAS bf16x8*)(lds + PG8_SB(b, h) + boff + n * 2048 + k * 1024); } while (0)
#define PG8_MMA(ai, bj, At, Bt) do { __builtin_amdgcn_s_setprio(1); _Pragma("unroll") for (int m = 0; m < 4; ++m) _Pragma("unroll") for (int n = 0; n < 2; ++n) _Pragma("unroll") for (int k = 0; k < 2; ++k) \
        acc[ai][bj][m][n] = __builtin_amdgcn_mfma_f32_16x16x32_bf16(Bt[n][k], At[m][k], acc[ai][bj][m][n], 0, 0, 0); __builtin_amdgcn_s_setprio(0); } while (0)
#define PG8_WAIT_V(n) asm volatile("s_waitcnt vmcnt(" #n ")" ::: "memory")
#define PG8_WAIT_L(n) asm volatile("s_waitcnt lgkmcnt(" #n ")" ::: "memory")
#define PG8_BAR __builtin_amdgcn_s_barrier()
#define PG8_SCHED __builtin_amdgcn_sched_barrier(0)
    Unit cur, nxt; int ui = 0;
    if (!S.next(0, cur)) return;
    f32x4 acc[2][2][4][2];
#pragma unroll
    for (int a = 0; a < 2; ++a)
#pragma unroll
        for (int b = 0; b < 2; ++b)
#pragma unroll
            for (int m = 0; m < 4; ++m)
#pragma unroll
                for (int n = 0; n < 2; ++n) acc[a][b][m][n] = (f32x4){0.f, 0.f, 0.f, 0.f};
    bf16x8 At[4][2], B0[2][2], B1[2][2];
    const char* cA = (const char*)g.A + (size_t)cur.pm * tstepA; const char* cB = (const char*)g.Bt + (size_t)cur.pn * tstepB;
    if constexpr (SP2) {
        PG8_STAGE(PG8_SB(0, 0), cB, voffB); PG8_STAGE(PG8_SB(0, 1), cB + hstepB, voffB); PG8_STAGE(PG8_SA(0, 0), cA, voffA); PG8_STAGE(PG8_SA(0, 1), cA + hstepA, voffA);
        if (wr == 1) PG8_BAR;
        PG8_WAIT_V(2); PG8_BAR;
        PG8_STAGE(PG8_SB(1, 0), cB + kstep, voffB); PG8_STAGE(PG8_SA(1, 0), cA + kstep, voffA); PG8_STAGE(PG8_SB(1, 1), cB + hstepB + kstep, voffB);
        PG8_WAIT_V(6); PG8_BAR;
    } else {
        PG8_STAGE(PG8_SB(0, 0), cB, voffB); PG8_STAGE(PG8_SA(0, 0), cA, voffA); PG8_STAGE(PG8_SB(0, 1), cB + hstepB, voffB); PG8_STAGE(PG8_SA(0, 1), cA + hstepA, voffA);
        if (wr == 1) PG8_BAR;
        PG8_WAIT_V(4); PG8_BAR;
        PG8_STAGE(PG8_SB(1, 0), cB + kstep, voffB); PG8_STAGE(PG8_SA(1, 0), cA + kstep, voffA); PG8_STAGE(PG8_SB(1, 1), cB + hstepB + kstep, voffB);
        PG8_WAIT_V(6); PG8_BAR;
    }
    for (;;) {
        const bool has_next = S.next(ui + 1, nxt);
        const char* nA = has_next ? (const char*)g.A + (size_t)nxt.pm * tstepA : cA; const char* nB = has_next ? (const char*)g.Bt + (size_t)nxt.pn * tstepB : cB;
#pragma nounroll
        for (int t = 0; t < nt; t += 2) {
            const bool last = (t == nt - 2);
            const char* a1 = cA + (size_t)(t + 1) * kstep;
            const char* a2 = last ? nA : cA + (size_t)(t + 2) * kstep; const char* b2 = last ? nB : cB + (size_t)(t + 2) * kstep;
            const char* a3 = a2 + kstep; const char* b3 = b2 + kstep;
            if constexpr (SP2) {
            PG8_LDB(B0, 0, 0); PG8_LDB(B1, 0, 1); PG8_SCHED; PG8_LDA(At, 0, 0); PG8_STAGE(PG8_SA(1, 1), a1 + hstepA, voffA);
            PG8_WAIT_V(8); PG8_WAIT_L(0); PG8_BAR; PG8_MMA(0, 0, At, B0); PG8_MMA(0, 1, At, B1); PG8_BAR; PG8_SCHED;
            PG8_LDA(At, 0, 1); PG8_STAGE(PG8_SB(0, 0), b2, voffB); PG8_STAGE(PG8_SB(0, 1), b2 + hstepB, voffB); PG8_STAGE(PG8_SA(0, 0), a2, voffA);
            PG8_WAIT_V(8); PG8_WAIT_L(0); PG8_BAR; PG8_MMA(1, 0, At, B0); PG8_MMA(1, 1, At, B1); PG8_BAR; PG8_SCHED;
            PG8_LDB(B0, 1, 0); PG8_LDB(B1, 1, 1); PG8_SCHED; PG8_LDA(At, 1, 0); PG8_STAGE(PG8_SA(0, 1), a2 + hstepA, voffA);
            PG8_WAIT_V(8); PG8_WAIT_L(0); PG8_BAR; PG8_MMA(0, 0, At, B0); PG8_MMA(0, 1, At, B1); PG8_BAR; PG8_SCHED;
            PG8_LDA(At, 1, 1); PG8_STAGE(PG8_SB(1, 0), b3, voffB); PG8_STAGE(PG8_SB(1, 1), b3 + hstepB, voffB); PG8_STAGE(PG8_SA(1, 0), a3, voffA);
            PG8_WAIT_V(8); PG8_WAIT_L(0); PG8_BAR; PG8_MMA(1, 0, At, B0); PG8_MMA(1, 1, At, B1); PG8_BAR; PG8_SCHED;
            } else {
            PG8_LDB(B0, 0, 0); PG8_SCHED; PG8_LDA(At, 0, 0); PG8_STAGE(PG8_SA(1, 1), a1 + hstepA, voffA);
            PG8_WAIT_L(8); PG8_BAR; PG8_WAIT_L(0); PG8_MMA(0, 0, At, B0); PG8_BAR; PG8_SCHED;
            PG8_LDB(B1, 0, 1); PG8_STAGE(PG8_SB(0, 0), b2, voffB);
            PG8_BAR; PG8_WAIT_L(0); PG8_MMA(0, 1, At, B1); PG8_BAR;
            PG8_LDA(At, 0, 1); PG8_STAGE(PG8_SA(0, 0), a2, voffA);
            PG8_BAR; PG8_WAIT_L(0); PG8_MMA(1, 0, At, B0); PG8_BAR; PG8_SCHED;
            PG8_STAGE(PG8_SB(0, 1), b2 + hstepB, voffB);
            PG8_WAIT_V(6); PG8_BAR; PG8_MMA(1, 1, At, B1); PG8_BAR;
            PG8_LDB(B0, 1, 0); PG8_SCHED; PG8_LDA(At, 1, 0); PG8_STAGE(PG8_SA(0, 1), a2 + hstepA, voffA);
            PG8_WAIT_L(8); PG8_BAR; PG8_WAIT_L(0); PG8_MMA(0, 0, At, B0); PG8_BAR; PG8_SCHED;
            PG8_LDB(B1, 1, 1); PG8_STAGE(PG8_SB(1, 0), b3, voffB);
            PG8_BAR; PG8_WAIT_L(0); PG8_MMA(0, 1, At, B1); PG8_BAR;
            PG8_LDA(At, 1, 1); PG8_STAGE(PG8_SA(1, 0), a3, voffA);
            PG8_BAR; PG8_WAIT_L(0); PG8_MMA(1, 0, At, B0); PG8_BAR; PG8_SCHED;
            PG8_STAGE(PG8_SB(1, 1), b3 + hstepB, voffB);
            PG8_WAIT_V(6); PG8_BAR; PG8_MMA(1, 1, At, B1); PG8_BAR;
            }
        }
        if constexpr (ALIGN_EPI) { if (wr == 0) PG8_BAR; }
        E(acc, cur, wr, wc, fr, fq);
        if (!has_next) break;
#pragma unroll
        for (int a = 0; a < 2; ++a)
#pragma unroll
            for (int b = 0; b < 2; ++b)
#pragma unroll
                for (int m = 0; m < 4; ++m)
#pragma unroll
                    for (int n = 0; n < 2; ++n) acc[a][b][m][n] = (f32x4){0.f, 0.f, 0.f, 0.f};
        cur = nxt; cA = nA; cB = nB; ++ui;
        if constexpr (ALIGN_EPI) { if (wr == 1) PG8_BAR; }
    }
    PG8_WAIT_V(0);
    if constexpr (!ALIGN_EPI) { if (wr == 0) PG8_BAR; }
    PG8_BAR;
#undef PG8_SA
#undef PG8_SB
#undef PG8_STAGE
#undef PG8_LDA
#undef PG8_LDB
#undef PG8_MMA
#undef PG8_WAIT_V
#undef PG8_WAIT_L
#undef PG8_BAR
#undef PG8_SCHED
}

#define EPI_ROWS(...) _Pragma("unroll") for (int ai = 0; ai < 2; ++ai) _Pragma("unroll") for (int m = 0; m < 4; ++m) { const int row = u.pm * BM + ai * HALF + wr * 64 + m * 16 + fr; __VA_ARGS__ }
__device__ __forceinline__ u32x4 pack8(f32x4 a, f32x4 b) { u32x4 w; w.x = cvtpk(a[0], a[1]); w.y = cvtpk(a[2], a[3]); w.z = cvtpk(b[0], b[1]); w.w = cvtpk(b[2], b[3]); return w; }
__device__ __forceinline__ u32x2 pack4(f32x4 a) { u32x2 w; w.x = cvtpk(a[0], a[1]); w.y = cvtpk(a[2], a[3]); return w; }
__device__ __forceinline__ float sq4(f32x4 a) { return (a[0] * a[0] + a[1] * a[1]) + (a[2] * a[2] + a[3] * a[3]); }
__device__ __forceinline__ float red_fq(float s) { s += __shfl_xor(s, 16); s += __shfl_xor(s, 32); return s; }

struct EpiMlaA {
    static constexpr bool PERM = false;
    const u64* ss_in; bf16_t* araw; u64* ssq; u64* sskv; bf16_t* kr; const float* rope;
    __device__ __forceinline__ void operator()(const Acc& acc, const Unit& u, int wr, int wc, int fr, int fq) const {
        EPI_ROWS(
            const float rs = 1.0f / sqrtf(ss_get(ss_in + row) * (1.0f / 1024.0f) + NEPS);
            _Pragma("unroll") for (int bj = 0; bj < 2; ++bj) {
                const int cg = u.pn * BM + bj * HALF + wc * 32;
                const f32x4 v0 = acc[ai][bj][m][0] * rs, v1 = acc[ai][bj][m][1] * rs;
                if (cg < 640) {
                    bf16_t* p = araw + (size_t)row * 768 + cg + 4 * fq;
                    *(u32x2*)p = pack4(v0); *(u32x2*)(p + 16) = pack4(v1);
                    const float s = red_fq(sq4(v0) + sq4(v1));
                    if (fq == 0) ss_add((cg < 384 ? ssq : sskv) + row, s);
                } else if (cg == 640) {
                    const f32x4 c = *(const f32x4*)(rope + (size_t)row * 16 + 4 * fq), sn = *(const f32x4*)(rope + (size_t)MTOK * 16 + (size_t)row * 16 + 4 * fq);
                    const f32x4 o1 = v0 * c - v1 * sn, o2 = v1 * c + v0 * sn;
                    bf16_t* p = kr + (size_t)row * 32 + 4 * fq;
                    *(u32x2*)p = pack4(o1); *(u32x2*)(p + 16) = pack4(o2);
                }
            })
    }
};
struct EpiMlaQ {
    static constexpr bool PERM = false;
    const u64* ssq; bf16_t* q; const float* rope;
    __device__ __forceinline__ void operator()(const Acc& acc, const Unit& u, int wr, int wc, int fr, int fq) const {
        EPI_ROWS(
            const float rs = C2_96 / sqrtf(ss_get(ssq + row) * (1.0f / 384.0f) + NEPS);
            _Pragma("unroll") for (int bj = 0; bj < 2; ++bj) {
                const int cg = u.pn * BM + bj * HALF + wc * 32;
                f32x4 v0 = acc[ai][bj][m][0] * rs, v1 = acc[ai][bj][m][1] * rs;
                if ((cg % 96) == 64) {
                    const f32x4 c = *(const f32x4*)(rope + (size_t)row * 16 + 4 * fq), sn = *(const f32x4*)(rope + (size_t)MTOK * 16 + (size_t)row * 16 + 4 * fq);
                    const f32x4 o1 = v0 * c - v1 * sn, o2 = v1 * c + v0 * sn; v0 = o1; v1 = o2;
                }
                bf16_t* p = q + (size_t)row * 1536 + cg + 4 * fq;
                *(u32x2*)p = pack4(v0); *(u32x2*)(p + 16) = pack4(v1);
            })
    }
};
struct EpiMlaKV {
    static constexpr bool PERM = true;
    const u64* sskv; bf16_t* kn; bf16_t* v;
    __device__ __forceinline__ void operator()(const Acc& acc, const Unit& u, int wr, int wc, int fr, int fq) const {
        EPI_ROWS(
            const float rs = 1.0f / sqrtf(ss_get(sskv + row) * (1.0f / 256.0f) + NEPS);
            _Pragma("unroll") for (int bj = 0; bj < 2; ++bj) {
                const int col0 = u.pn * BM + bj * HALF + wc * 32 + 8 * fq, head = col0 >> 7, w = col0 & 127;
                bf16_t* p = (w < 64 ? kn + w : v + (w - 64)) + (size_t)row * 1024 + head * 64;
                *(u32x4*)p = pack8(acc[ai][bj][m][0] * rs, acc[ai][bj][m][1] * rs);
            })
    }
};
__device__ __forceinline__ float lsig(float z) { return fminf(z, 0.f) - __logf(1.0f + __expf(-fabsf(z))); }
struct EpiQKV {
    static constexpr bool PERM = true;
    const u64* ss_in; bf16_t* qp; size_t segstride; int ld; float* lf; const float* bfv;
    __device__ __forceinline__ void operator()(const Acc& acc, const Unit& u, int wr, int wc, int fr, int fq) const {
        EPI_ROWS(
            const float rs = 1.0f / sqrtf(ss_get(ss_in + row) * (1.0f / 1024.0f) + NEPS);
            _Pragma("unroll") for (int bj = 0; bj < 2; ++bj) {
                const int col0 = u.pn * BM + bj * HALF + wc * 32 + 8 * fq, seg = col0 >> 10, w = col0 & 1023;
                if (seg < 3) {
                    const float sc = (seg == 0) ? rs * C2_64 : rs;
                    bf16_t* p = qp + (size_t)seg * segstride + (size_t)row * ld + w;
                    *(u32x4*)p = pack8(acc[ai][bj][m][0] * sc, acc[ai][bj][m][1] * sc);
                } else if (lf != nullptr && col0 < 3088) {
                    const f32x4 z0 = acc[ai][bj][m][0] * rs, z1 = acc[ai][bj][m][1] * rs; const int hb = col0 - 3072; float* lp = lf + (size_t)row * 16 + hb; const float* bp = bfv + hb;
                    lp[0] = lsig(z0[0] + bp[0]); lp[1] = lsig(z0[1] + bp[1]); lp[2] = lsig(z0[2] + bp[2]); lp[3] = lsig(z0[3] + bp[3]);
                    lp[4] = lsig(z1[0] + bp[4]); lp[5] = lsig(z1[1] + bp[5]); lp[6] = lsig(z1[2] + bp[6]); lp[7] = lsig(z1[3] + bp[7]);
                }
            })
    }
};
template <bool SS> struct EpiY {
    static constexpr bool PERM = true;
    bf16_t* y; u64* ss;
    __device__ __forceinline__ void operator()(const Acc& acc, const Unit& u, int wr, int wc, int fr, int fq) const {
        EPI_ROWS(
            float s = 0.f;
            _Pragma("unroll") for (int bj = 0; bj < 2; ++bj) {
                const int col0 = u.pn * BM + bj * HALF + wc * 32 + 8 * fq;
                const f32x4 v0 = acc[ai][bj][m][0], v1 = acc[ai][bj][m][1];
                *(u32x4*)(y + (size_t)row * 1024 + col0) = pack8(v0, v1);
                if (SS) s += sq4(v0) + sq4(v1);
            }
            if (SS) { s = red_fq(s); if (fq == 0) ss_add(ss + row, s); })
    }
};
struct EpiSwiglu {
    static constexpr bool PERM = false;
    bf16_t* act;
    __device__ __forceinline__ void operator()(const Acc& acc, const Unit& u, int wr, int wc, int fr, int fq) const {
        EPI_ROWS(
            _Pragma("unroll") for (int bj = 0; bj < 2; ++bj) {
                const int oc = (u.pn * BM + bj * HALF + wc * 32) / 2 + 4 * fq;
                const f32x4 gt = acc[ai][bj][m][0], up = acc[ai][bj][m][1]; f32x4 r;
                _Pragma("unroll") for (int e = 0; e < 4; ++e) r[e] = gt[e] * sigmoidf_(gt[e]) * up[e];
                *(u32x2*)(act + (size_t)row * DFF + oc) = pack4(r);
            })
    }
};
struct EpiGate {
    static constexpr bool PERM = true;
    float* h; const bf16_t* pp; bf16_t* xn; u64* ss;
    __device__ __forceinline__ void operator()(const Acc& acc, const Unit& u, int wr, int wc, int fr, int fq) const {
        EPI_ROWS(
            float s = 0.f;
            _Pragma("unroll") for (int bj = 0; bj < 2; ++bj) {
                const int col0 = u.pn * BM + bj * HALF + wc * 32 + 8 * fq;
                float* hp = h + (size_t)row * 1024 + col0;
                f32x4 h0 = *(const f32x4*)hp, h1 = *(const f32x4*)(hp + 4);
                const u32x4 pw = *(const u32x4*)(pp + (size_t)row * 1024 + col0);
                const f32x4 p0 = {bf_lo(pw.x), bf_hi(pw.x), bf_lo(pw.y), bf_hi(pw.y)}, p1 = {bf_lo(pw.z), bf_hi(pw.z), bf_lo(pw.w), bf_hi(pw.w)};
                const f32x4 g0 = acc[ai][bj][m][0], g1 = acc[ai][bj][m][1];
                _Pragma("unroll") for (int e = 0; e < 4; ++e) { h0[e] += p0[e] * sigmoidf_(g0[e]); h1[e] += p1[e] * sigmoidf_(g1[e]); }
                *(f32x4*)hp = h0; *(f32x4*)(hp + 4) = h1;
                if (xn) { *(u32x4*)(xn + (size_t)row * 1024 + col0) = pack8(h0, h1); s += sq4(h0) + sq4(h1); }
            }
            if (ss) { s = red_fq(s); if (fq == 0) ss_add(ss + row, s); })
    }
};
#undef EPI_ROWS
}
namespace att {
constexpr int MODE_CAUSAL = 0, MODE_FOX = 1, MODE_DIL = 2;
__device__ __forceinline__ int crow(int r, int hi) { return (r & 3) + 8 * (r >> 2) + 4 * hi; }
typedef short v4i16_t __attribute__((ext_vector_type(4)));
__device__ __forceinline__ s16x4 vtr(const LAS char* p) { return __builtin_bit_cast(s16x4, __builtin_amdgcn_ds_read_tr16_b64_v4i16((LAS v4i16_t*)p)); }

constexpr int KSLOT = 12288, VSLOT = 8192, STREAM_BYTES = 2 * KSLOT + 2 * VSLOT;
constexpr int L_WSF = 2 * STREAM_BYTES;
constexpr int L_OST = L_WSF + 8 * 512;
constexpr int L_TAB = L_OST + 8 * 4096;
static_assert(L_TAB + 8192 <= RING_BYTES, "attention LDS map");

struct Stream {
    const bf16_t* q; const bf16_t* k; const bf16_t* kr; const bf16_t* v; bf16_t* o; float* lse;
    int ldq, ldk, ldv, ldo; int row0, rstep; int qs0  , kt0  , nt  ; int head; int merge;
};

template <int GW, int DK, int MODE>
__device__ __forceinline__ void run_unit(LAS unsigned char* lds, const Stream& S, int wid, int lane) {
    constexpr int NPK = DK / 8;
    constexpr int SPAN = 128;
    const int r32 = lane & 31, hi = lane >> 5;
    const int sidx = (GW == 8) ? 0 : (wid >> 2), wg = (GW == 8) ? wid : (wid & 3);
    LAS unsigned char* sb = lds + sidx * STREAM_BYTES;
    LAS float* wsf = (LAS float*)(lds + L_WSF + wid * 512);
    LAS unsigned char* ost = lds + L_OST + wid * 4096;
    LAS float* tab = (LAS float*)(lds + L_TAB + ((MODE == MODE_DIL) ? sidx * 1024 : 0));
    const int qsw = S.qs0 + wg * 32;
    auto dma_tile = [&](int t, int b) {
        const int kbase = S.kt0 + 64 * t;
        if (kbase + 63 < 0) return;
        {   int ki = kbase + lane; ki = ki < 0 ? 0 : ki; const size_t rowk = (size_t)(S.row0 + ki * S.rstep);
#pragma unroll
            for (int p = wg; p < NPK; p += GW) {
                const bf16_t* src = (p < 8) ? S.k + rowk * S.ldk + p * 8 : S.kr + rowk * 32 + (p - 8) * 8;
                __builtin_amdgcn_global_load_lds((const unsigned*)src, (LAS unsigned*)(sb + b * KSLOT + p * 1024), 16, 0, 0); } }
#pragma unroll
        for (int p = wg; p < 8; p += GW) {
            int ki = kbase + 16 * (p & 3) + (lane >> 2); ki = ki < 0 ? 0 : ki;
            const bf16_t* src = S.v + (size_t)(S.row0 + ki * S.rstep) * S.ldv + (p >> 2) * 32 + (lane & 3) * 8;
            __builtin_amdgcn_global_load_lds((const unsigned*)src, (LAS unsigned*)(sb + 2 * KSLOT + b * VSLOT + p * 1024), 16, 0, 0); }
    };
    dma_tile(0, 0);
    bf16x8 qr[DK / 16];
    { const bf16_t* qp = S.q + (size_t)(S.row0 + (qsw + r32) * S.rstep) * S.ldq + hi * 8;
#pragma unroll
      for (int d0 = 0; d0 < DK / 16; ++d0) qr[d0] = *(const bf16x8*)(qp + d0 * 16); }
    f32x16 o0 = {}, o1 = {};
    float m = -1.0e30f, l = 0.f;
    const int myq = qsw + r32;
    __syncthreads();
    for (int t = 0; t < S.nt; ++t) {
        const int b = t & 1;
        if (t + 1 < S.nt) dma_tile(t + 1, b ^ 1);
        const int kmin = S.kt0 + 64 * t, kmax = kmin + 63;
        bool active = (kmin <= qsw + 31) && (kmax >= 0);
        if (MODE == MODE_DIL) active = active && (kmax >= qsw - SPAN);
        if (active) {
            const LAS unsigned char* Ks = sb + b * KSLOT; const LAS unsigned char* Vs = sb + 2 * KSLOT + b * VSLOT;
            f32x16 p0, p1;
            if (MODE == MODE_FOX) {
#pragma unroll
                for (int r = 0; r < 16; ++r) { p0[r] = tab[kmin + crow(r, hi)]; p1[r] = tab[kmin + 32 + crow(r, hi)]; }
            } else { p0 = f32x16{}; p1 = f32x16{}; }
            const LAS unsigned char* kb = Ks + hi * 1024 + r32 * 16;
#pragma unroll
            for (int d0 = 0; d0 < DK / 16; ++d0) {
                const bf16x8 k0 = *(const LAS bf16x8*)(kb + d0 * 2048), k1 = *(const LAS bf16x8*)(kb + d0 * 2048 + 512);
                p0 = __builtin_amdgcn_mfma_f32_32x32x16_bf16(k0, qr[d0], p0, 0, 0, 0);
                p1 = __builtin_amdgcn_mfma_f32_32x32x16_bf16(k1, qr[d0], p1, 0, 0, 0);
            }
            if (MODE == MODE_DIL) {
#pragma unroll
                for (int r = 0; r < 16; ++r) {
                    const int k0i = kmin + crow(r, hi), k1i = k0i + 32; const int rel0 = myq - k0i, rel1 = myq - k1i;
                    const bool v0 = (rel0 >= 0) && (rel0 <= SPAN) && (k0i >= 0), v1 = (rel1 >= 0) && (rel1 <= SPAN) && (k1i >= 0);
                    const float b0 = tab[v0 ? rel0 : 0], b1 = tab[v1 ? rel1 : 0];
                    p0[r] = v0 ? p0[r] + b0 : -INFINITY; p1[r] = v1 ? p1[r] + b1 : -INFINITY; }
            } else if (kmax > qsw) {
#pragma unroll
                for (int r = 0; r < 16; ++r) { const int k0i = kmin + crow(r, hi);
                    if (k0i > myq) p0[r] = -INFINITY; if (k0i + 32 > myq) p1[r] = -INFINITY; }
            }
            float rm = fmaxf(p0[0], p1[0]);
#pragma unroll
            for (int r = 1; r < 16; ++r) rm = fmaxf(rm, fmaxf(p0[r], p1[r]));
            rm = fmaxf(rm, __shfl_xor(rm, 32));
            const float mn = fmaxf(m, rm);
            const float alpha = __builtin_amdgcn_exp2f(m - mn);
            const bool resc = __any(mn > m);
            m = mn;
            float ls = 0.f;
#pragma unroll
            for (int r = 0; r < 16; ++r) { p0[r] = __builtin_amdgcn_exp2f(p0[r] - mn); p1[r] = __builtin_amdgcn_exp2f(p1[r] - mn); ls += p0[r] + p1[r]; }
            l = l * alpha + ls;
            if (resc) {
                if (hi == 0) wsf[r32] = alpha;
#pragma unroll
                for (int r = 0; r < 16; ++r) { const float a = wsf[crow(r, hi)]; o0[r] *= a; o1[r] *= a; }
            }
            u32x4 pw[4];
#pragma unroll
            for (int j = 0; j < 4; ++j) { pw[0][j] = cvtpk(p0[2 * j], p0[2 * j + 1]); pw[1][j] = cvtpk(p0[8 + 2 * j], p0[8 + 2 * j + 1]);
                                          pw[2][j] = cvtpk(p1[2 * j], p1[2 * j + 1]); pw[3][j] = cvtpk(p1[8 + 2 * j], p1[8 + 2 * j + 1]); }
            const LAS char* vp = (const LAS char*)Vs + ((lane >> 4) & 1) * 32 + (lane & 3) * 8 + (4 * hi + ((lane & 15) >> 2)) * 64;
#pragma unroll
            for (int ks = 0; ks < 4; ++ks) {
                const s16x4 a0 = vtr(vp + ks * 1024), a1 = vtr(vp + ks * 1024 + 512), c0 = vtr(vp + 4096 + ks * 1024), c1 = vtr(vp + 4096 + ks * 1024 + 512);
                const bf16x8 vf0 = {a0[0], a0[1], a0[2], a0[3], a1[0], a1[1], a1[2], a1[3]}, vf1 = {c0[0], c0[1], c0[2], c0[3], c1[0], c1[1], c1[2], c1[3]};
                const bf16x8 pa = __builtin_bit_cast(bf16x8, pw[ks]);
                o0 = __builtin_amdgcn_mfma_f32_32x32x16_bf16(pa, vf0, o0, 0, 0, 0);
                o1 = __builtin_amdgcn_mfma_f32_32x32x16_bf16(pa, vf1, o1, 0, 0, 0);
            }
        }
        __syncthreads();
    }
    l += __shfl_xor(l, 32);
    if (hi == 0) { wsf[r32] = 1.0f / l; wsf[32 + r32] = m + __builtin_amdgcn_logf(l); }
    LAS bf16_t* stg = (LAS bf16_t*)ost;
#pragma unroll
    for (int r = 0; r < 16; ++r) { const float il = wsf[crow(r, hi)]; const int orow = crow(r, hi);
        stg[orow * 64 + r32] = (bf16_t)(cvtpk(o0[r] * il, 0.f) & 0xffffu); stg[orow * 64 + 32 + r32] = (bf16_t)(cvtpk(o1[r] * il, 0.f) & 0xffffu); }
    asm volatile("s_waitcnt lgkmcnt(0)" ::: "memory");
#pragma unroll
    for (int i = 0; i < 4; ++i) {
        const int row = i * 8 + (lane >> 3), ch = lane & 7;
        u32x4 vnew = *(const LAS u32x4*)(stg + row * 64 + ch * 8);
        const size_t grow = (size_t)(S.row0 + (qsw + row) * S.rstep);
        bf16_t* op = S.o + grow * S.ldo + ch * 8;
        if (MODE == MODE_DIL) {
            const float ln = wsf[32 + row]; float* lp = S.lse + grow * 16 + S.head;
            if (S.merge) {
                const float lo = *lp; const u32x4 vold = *(const u32x4*)op;
                const float mx = fmaxf(lo, ln), wo = __builtin_amdgcn_exp2f(lo - mx), wn = __builtin_amdgcn_exp2f(ln - mx), inv = 1.0f / (wo + wn), a = wo * inv, c = wn * inv;
                u32x4 res;
#pragma unroll
                for (int e = 0; e < 4; ++e) res[e] = cvtpk(a * bf_lo(vold[e]) + c * bf_lo(vnew[e]), a * bf_hi(vold[e]) + c * bf_hi(vnew[e]));
                vnew = res;
                if (ch == 0) *lp = mx + __builtin_amdgcn_logf(wo + wn);
            } else if (ch == 0) *lp = ln;
        }
        *(u32x4*)op = vnew;
    }
    __syncthreads();
}
}
namespace cg = cooperative_groups;
constexpr int NTHREADS = 512, NWAVES = 8;
constexpr int N_PHASES = 39;

struct Ctx {
    LAS unsigned char* lds; int tid, lane, wave, vcu, G, gw, ngw;
    const __attribute__((address_space(4))) void* ka; float* H; unsigned char* ws; int bx;
};
__device__ __forceinline__ const float* INP(const Ctx& C, int i) { return ((const float* const __attribute__((address_space(4)))*)C.ka)[i]; }
__device__ __forceinline__ Ctx make_ctx(LAS unsigned char* lds) {
    Ctx C; C.lds = lds; int tid = threadIdx.x; asm volatile("" : "+v"(tid)); C.tid = tid; C.lane = tid & 63; C.wave = __builtin_amdgcn_readfirstlane(tid >> 6);
    int G = gridDim.x, bx = blockIdx.x; asm volatile("" : "+s"(G), "+s"(bx)); C.G = G; C.bx = bx; C.vcu = (G % 8 == 0) ? (bx % 8) * (G / 8) + bx / 8 : bx;
    C.gw = C.vcu * NWAVES + C.wave; C.ngw = G * NWAVES;
    const __attribute__((address_space(4))) void* ka = (const __attribute__((address_space(4))) void*)__builtin_amdgcn_kernarg_segment_ptr(); asm volatile("" : "+s"(ka)); C.ka = ka;
    C.H = ((const __attribute__((address_space(4))) Args*)ka)->out; C.ws = ((const __attribute__((address_space(4))) Args*)ka)->ws; return C;
}
__device__ __forceinline__ u64* ss_arr(const Ctx& C, int idx) { return (u64*)(C.ws + WS_SS) + (size_t)idx * MTOK; }

__device__ __forceinline__ void cvt_mixer(const Ctx& C, int layer) {
    const int mixer = layer % 3, j = layer / 3; const float* g0 = INP(C, 3) + (size_t)layer * 4096;
    bf16_t* wmix = (bf16_t*)(C.ws + WS_WMIX); bf16_t* wo = (bf16_t*)(C.ws + WS_WO);
    if (mixer == 0) {
        cvt_run(CvtJob{INP(C, 9) + (size_t)j * 1024 * 672, wmix, g0, 1024, 672, 768, 0}, C.gw, C.ngw, C.lane);
        cvt_run(CvtJob{INP(C, 12) + (size_t)j * 384 * 1536, (bf16_t*)(C.ws + WS_WMIX + 2 * MiB), INP(C, 10) + j * 384, 384, 1536, 1536, 0}, C.gw, C.ngw, C.lane);
        cvt_run(CvtJob{INP(C, 13) + (size_t)j * 256 * 2048, (bf16_t*)(C.ws + WS_WMIX + 4 * MiB), INP(C, 11) + j * 256, 256, 2048, 2048, 0}, C.gw, C.ngw, C.lane);
        cvt_run(CvtJob{INP(C, 14) + (size_t)j * 1024 * 1024, wo, nullptr, 1024, 1024, 1024, 0}, C.gw, C.ngw, C.lane);
    } else if (mixer == 1) {
        cvt_run(CvtJob{INP(C, 15) + (size_t)j * 1024 * 9216, wmix, g0, 1024, 9216, 9216, 0}, C.gw, C.ngw, C.lane);
        cvt_run(CvtJob{INP(C, 16) + (size_t)j * 1024 * 1024, wo, nullptr, 1024, 1024, 1024, 0}, C.gw, C.ngw, C.lane);
    } else {
        cvt_run(CvtJob{INP(C, 17) + (size_t)j * 1024 * 3088, wmix, g0, 1024, 3088, 3328, 0}, C.gw, C.ngw, C.lane);
        cvt_run(CvtJob{INP(C, 19) + (size_t)j * 1024 * 1024, wo, nullptr, 1024, 1024, 1024, 0}, C.gw, C.ngw, C.lane);
    }
}
__device__ __forceinline__ void cvt_ffn(const Ctx& C, int layer) {
    cvt_run(CvtJob{INP(C, 4) + (size_t)layer * 1024 * 5632, (bf16_t*)(C.ws + WS_WIN), nullptr, 1024, 5632, 5632, 1}, C.gw, C.ngw, C.lane);
    cvt_run(CvtJob{INP(C, 5) + (size_t)layer * 2816 * 1024, (bf16_t*)(C.ws + WS_WOUT), nullptr, 2816, 1024, 1024, 0}, C.gw, C.ngw, C.lane);
}
__device__ __forceinline__ void cvt_ple(const Ctx& C, int layer) {
    cvt_run(CvtJob{INP(C, 6) + (size_t)layer * 256 * 1024, (bf16_t*)(C.ws + WS_WPROJ), nullptr, 256, 1024, 1024, 0}, C.gw, C.ngw, C.lane);
    cvt_run(CvtJob{INP(C, 7) + (size_t)layer * 1024 * 1024, (bf16_t*)(C.ws + WS_WGATE), nullptr, 1024, 1024, 1024, 0}, C.gw, C.ngw, C.lane);
}

__device__ __forceinline__ int t5_bucket(int dist) {
    if (dist < 16) return dist;
    const float n = (float)dist;
    int large = 16 + (int)(logf(n / 16.0f) / 4.852030263919617f * 16.0f);
    return large < 31 ? large : 31;
}

struct Row16 { f32x4 a[4]; };
__device__ __forceinline__ Row16 ld_row_f32(const float* p, int lane) { Row16 r; const f32x4* q = (const f32x4*)(p + 8 * lane); r.a[0] = q[0]; r.a[1] = q[1]; q = (const f32x4*)(p + 512 + 8 * lane); r.a[2] = q[0]; r.a[3] = q[1]; return r; }
__device__ __forceinline__ void st_row_f32(float* p, int lane, const Row16& r) { f32x4* q = (f32x4*)(p + 8 * lane); q[0] = r.a[0]; q[1] = r.a[1]; q = (f32x4*)(p + 512 + 8 * lane); q[0] = r.a[2]; q[1] = r.a[3]; }
__device__ __forceinline__ Row16 ld_row_bf16(const bf16_t* p, int lane) { Row16 r; const u32x4 w0 = *(const u32x4*)(p + 8 * lane), w1 = *(const u32x4*)(p + 512 + 8 * lane);
    r.a[0] = (f32x4){bf_lo(w0.x), bf_hi(w0.x), bf_lo(w0.y), bf_hi(w0.y)}; r.a[1] = (f32x4){bf_lo(w0.z), bf_hi(w0.z), bf_lo(w0.w), bf_hi(w0.w)};
    r.a[2] = (f32x4){bf_lo(w1.x), bf_hi(w1.x), bf_lo(w1.y), bf_hi(w1.y)}; r.a[3] = (f32x4){bf_lo(w1.z), bf_hi(w1.z), bf_lo(w1.w), bf_hi(w1.w)}; return r; }
__device__ __forceinline__ void st_row_bf16(bf16_t* p, int lane, const Row16& r) { *(u32x4*)(p + 8 * lane) = pg8::pack8(r.a[0], r.a[1]); *(u32x4*)(p + 512 + 8 * lane) = pg8::pack8(r.a[2], r.a[3]); }
__device__ __forceinline__ float row_ss(const Row16& r) { return wave_sum((pg8::sq4(r.a[0]) + pg8::sq4(r.a[1])) + (pg8::sq4(r.a[2]) + pg8::sq4(r.a[3]))); }

__device__ __forceinline__ void ph_prologue(const Ctx& C) {
    { u32x4* z = (u32x4*)(C.ws + WS_SS); for (int i = C.gw * 64 + C.lane; i < (int)(2 * MiB / 16); i += C.ngw * 64) z[i] = (u32x4){0u, 0u, 0u, 0u}; }
    cvt_mixer(C, 0); cvt_ffn(C, 0); cvt_ple(C, 0);
    { float* rc = (float*)(C.ws + WS_ROPE); const int* pos = (const int*)INP(C, 2);
      for (int i = C.gw * 64 + C.lane; i < MTOK * 16; i += C.ngw * 64) { const int row = i >> 4, f = i & 15;
          const float inv = powf(10000.0f, -(float)f / 16.0f); const float ang = (float)pos[row] * inv;
          const double ad = (double)ang, twopi = 6.283185307179586476925; const float r = (float)(ad - rint(ad / twopi) * twopi);
          rc[i] = cosf(r); rc[MTOK * 16 + i] = sinf(r); } }
    { float* bt = (float*)(C.ws + WS_BIAS); const float* rb = INP(C, 8);
      for (int i = C.gw * 64 + C.lane; i < 3 * 16 * 132; i += C.ngw * 64) { const int g = i / (16 * 132), h = (i / 132) % 16, rel = i % 132; const int d = (g == 0) ? 1 : (g == 1) ? 4 : 16;
          bt[i] = (rel <= 128) ? rb[t5_bucket(rel * d) * 48 + g * 16 + h] * LOG2E : 0.f; } }
    { const float* x = INP(C, 0); bf16_t* xn1 = (bf16_t*)(C.ws + WS_XN1); u64* ss = ss_arr(C, SS_IN + 0);
      for (int row = C.gw; row < MTOK; row += C.ngw) { const Row16 r = ld_row_f32(x + (size_t)row * 1024, C.lane);
          st_row_f32(C.H + (size_t)row * 1024, C.lane, r); st_row_bf16(xn1 + (size_t)row * 1024, C.lane, r);
          const float s = row_ss(r); if (C.lane == 0) ss[row] = (u64)(s * SS_SCALE + 0.5f); } }
}
__device__ __forceinline__ void ph_r1(const Ctx& C, int layer, float dsc = 1.0f) {
    const bf16_t* y = (const bf16_t*)(C.ws + WS_BIG + BIG_Y); bf16_t* xn0 = (bf16_t*)(C.ws + WS_XN0); const u64* ssy = ss_arr(C, SS_Y1 + layer);
    const float* g1 = INP(C, 3) + (size_t)layer * 4096 + 1024; const float* g2 = g1 + 1024;
    const Row16 G1 = ld_row_f32(g1, C.lane), G2 = ld_row_f32(g2, C.lane);
    for (int row = C.gw; row < MTOK; row += C.ngw) {
        Row16 h = ld_row_f32(C.H + (size_t)row * 1024, C.lane); const Row16 yv = ld_row_bf16(y + (size_t)row * 1024, C.lane);
        const float rs = 1.0f / sqrtf(ss_get(ssy + row) * (1.0f / 1024.0f) + NEPS);
#pragma unroll
        for (int i = 0; i < 4; ++i) h.a[i] += yv.a[i] * (rs * dsc) * G1.a[i];
        st_row_f32(C.H + (size_t)row * 1024, C.lane, h);
        const float rs2 = 1.0f / sqrtf(row_ss(h) * (1.0f / 1024.0f) + NEPS);
#pragma unroll
        for (int i = 0; i < 4; ++i) h.a[i] = h.a[i] * rs2 * G2.a[i];
        st_row_bf16(xn0 + (size_t)row * 1024, C.lane, h);
    }
    if (layer + 1 < 4) cvt_mixer(C, layer + 1);
    if (layer > 0) cvt_ple(C, layer);
}
__device__ __forceinline__ void ph_r2(const Ctx& C, int layer, float dsc = 1.0f) {
    const bf16_t* y = (const bf16_t*)(C.ws + WS_BIG + BIG_Y2); bf16_t* xn0 = (bf16_t*)(C.ws + WS_XN0); const u64* ssy = ss_arr(C, SS_Y2 + layer);
    const float* g3 = INP(C, 3) + (size_t)layer * 4096 + 3072; const Row16 G3 = ld_row_f32(g3, C.lane);
    const float* p = INP(C, 1) + (size_t)layer * MTOK * 256; bf16_t* pbf = (bf16_t*)(C.ws + WS_BIG + BIG_PBF);
    for (int row = C.gw; row < MTOK; row += C.ngw) {
        Row16 h = ld_row_f32(C.H + (size_t)row * 1024, C.lane); const Row16 yv = ld_row_bf16(y + (size_t)row * 1024, C.lane);
        const float rs = 1.0f / sqrtf(ss_get(ssy + row) * (1.0f / 1024.0f) + NEPS);
#pragma unroll
        for (int i = 0; i < 4; ++i) h.a[i] += yv.a[i] * (rs * dsc) * G3.a[i];
        st_row_f32(C.H + (size_t)row * 1024, C.lane, h); st_row_bf16(xn0 + (size_t)row * 1024, C.lane, h);
        const f32x4 pv = *(const f32x4*)(p + (size_t)row * 256 + 4 * C.lane);
        *(u32x2*)(pbf + (size_t)row * 256 + 4 * C.lane) = pg8::pack4(pv);
    }
    if (layer + 1 < 4) cvt_ffn(C, layer + 1);
}
template <class Epi> __device__ __forceinline__ void run_gemm(const Ctx& C, const bf16_t* A, int lda, const bf16_t* Bt, int ldb, int N, int K, const Epi& E) {
    pg8::Gemm g{A, Bt, lda, ldb, MTOK, N, K}; pg8::StaticOrder S; S.init(MTOK, N, C.G, C.bx);
    pg8::gemm_phase<Epi, true, true>(C.lds, g, S, E, C.tid);
}
template <int DK, int MODE> __device__ __forceinline__ void ph_attn_causal(const Ctx& C) {
    const int bh = C.vcu >> 1, b = bh >> 4, h = bh & 15, s = C.vcu & 1;
    if (MODE == att::MODE_FOX) {
        LAS float* tab = (LAS float*)(C.lds + att::L_TAB); LAS float* wt = (LAS float*)(C.lds + att::L_WSF);
        const float* lf = (const float*)(C.ws + WS_LF) + (size_t)b * SEQL * 16 + h;
        float c[4]; float run = 0.f;
#pragma unroll
        for (int e = 0; e < 4; ++e) { run += lf[(size_t)(4 * C.tid + e) * 16]; c[e] = run; }
        float sc = run;
#pragma unroll
        for (int o = 1; o < 64; o <<= 1) { const float v = __shfl_up(sc, o); if (C.lane >= o) sc += v; }
        if (C.lane == 63) wt[C.wave] = sc;
        __syncthreads();
        float base = sc - run;
        for (int w = 0; w < C.wave; ++w) base += wt[w];
#pragma unroll
        for (int e = 0; e < 4; ++e) tab[4 * C.tid + e] = -(base + c[e]) * LOG2E;
        __syncthreads();
    }
    for (int i = 0; i < 4; ++i) {
        const int qb = (i == 0) ? 7 - s : (i == 1) ? s : (i == 2) ? 5 - s : 2 + s;
        att::Stream S;
        if (DK == 96) { S.q = (const bf16_t*)(C.ws + WS_BIG + BIG_Q) + h * 96; S.ldq = 1536; S.k = (const bf16_t*)(C.ws + WS_BIG + BIG_KN) + h * 64; S.v = (const bf16_t*)(C.ws + WS_BIG + BIG_V) + h * 64; S.kr = (const bf16_t*)(C.ws + WS_KR); }
        else { S.q = (const bf16_t*)(C.ws + WS_BIG + BIG_FQ) + h * 64; S.ldq = 1024; S.k = (const bf16_t*)(C.ws + WS_BIG + BIG_FK) + h * 64; S.v = (const bf16_t*)(C.ws + WS_BIG + BIG_FV) + h * 64; S.kr = nullptr; }
        S.ldk = 1024; S.ldv = 1024; S.o = (bf16_t*)(C.ws + WS_BIG + BIG_O) + h * 64; S.ldo = 1024; S.lse = nullptr;
        S.row0 = b * SEQL; S.rstep = 1; S.qs0 = 256 * qb; S.kt0 = 0; S.nt = 4 * (qb + 1); S.head = h; S.merge = 0;
        att::run_unit<8, DK, MODE>(C.lds, S, C.wave, C.lane);
    }
}
__device__ __forceinline__ void ph_attn_dil(const Ctx& C, int g) {
    const int bh = C.vcu >> 1, b = bh >> 4, h = bh & 15; const int d = (g == 0) ? 1 : (g == 1) ? 4 : 16;
    { const float* bt = (const float*)(C.ws + WS_BIAS) + (size_t)(g * 16 + h) * 132; LAS float* tab = (LAS float*)(C.lds + att::L_TAB);
      if (C.tid < 132) { const float v = bt[C.tid]; tab[C.tid] = v; tab[256 + C.tid] = v; }
      __syncthreads(); }
    const bf16_t* qkv = (const bf16_t*)(C.ws + WS_BIG + BIG_QKVG);
    for (int i = 0; i < 4; ++i) {
        const int su = 8 * C.vcu + 2 * i + (C.wave >> 2), x = su & 15;
        const int r = (d == 1) ? 0 : (d == 4) ? (x & 3) : x, n = (d == 1) ? x : (d == 4) ? (x >> 2) : 0;
        att::Stream S;
        S.q = qkv + h * 64; S.k = qkv + 1024 + h * 64; S.v = qkv + 2048 + h * 64; S.kr = nullptr; S.ldq = 3072; S.ldk = 3072; S.ldv = 3072;
        S.o = (bf16_t*)(C.ws + WS_BIG + BIG_O) + h * 64; S.ldo = 1024; S.lse = (float*)(C.ws + WS_LSE);
        S.row0 = b * SEQL + r; S.rstep = d; S.qs0 = 128 * n; S.kt0 = 128 * n - 128; S.nt = 4; S.head = h; S.merge = (g > 0);
        att::run_unit<4, 64, att::MODE_DIL>(C.lds, S, C.wave, C.lane);
    }
}
__device__ __forceinline__ void ph_common(const Ctx& C, int layer, int st) {
    unsigned char* big = C.ws + WS_BIG;
    switch (st) {
    case 0: run_gemm(C, (const bf16_t*)(big + BIG_O), 1024, (const bf16_t*)(C.ws + WS_WO), 1024, 1024, 1024, pg8::EpiY<true>{(bf16_t*)(big + BIG_Y), ss_arr(C, SS_Y1 + layer)}); break;
    case 1: ph_r1(C, layer); break;
    case 2: run_gemm(C, (const bf16_t*)(C.ws + WS_XN0), 1024, (const bf16_t*)(C.ws + WS_WIN), 1024, 5632, 1024, pg8::EpiSwiglu{(bf16_t*)(big + BIG_ACT)}); break;
    case 3: run_gemm(C, (const bf16_t*)(big + BIG_ACT), DFF, (const bf16_t*)(C.ws + WS_WOUT), DFF, 1024, DFF, pg8::EpiY<true>{(bf16_t*)(big + BIG_Y2), ss_arr(C, SS_Y2 + layer)}); break;
    case 4: ph_r2(C, layer); break;
    default: {
        run_gemm(C, (const bf16_t*)(big + BIG_PBF), 256, (const bf16_t*)(C.ws + WS_WPROJ), 256, 1024, 256, pg8::EpiY<false>{(bf16_t*)(big + BIG_PP), nullptr});
        asm volatile("s_waitcnt vmcnt(0)" ::: "memory"); __builtin_amdgcn_fence(__ATOMIC_RELEASE, "agent"); asm volatile("s_waitcnt vmcnt(0)" ::: "memory");
        __syncthreads(); __builtin_amdgcn_fence(__ATOMIC_ACQUIRE, "agent"); asm volatile("s_waitcnt vmcnt(0)" ::: "memory"); __syncthreads();
        const bool lastl = (layer == 3); const Ctx C2 = make_ctx(C.lds);
        run_gemm(C2, (const bf16_t*)(C2.ws + WS_XN0), 1024, (const bf16_t*)(C2.ws + WS_WGATE), 1024, 1024, 1024,
                 pg8::EpiGate{C2.H, (const bf16_t*)(C2.ws + WS_BIG + BIG_PP), lastl ? nullptr : (bf16_t*)(C2.ws + WS_XN1), lastl ? nullptr : ss_arr(C2, SS_IN + layer + 1)});
    } }
}
__device__ __forceinline__ void run_phase(const Ctx& C, int ph) {
    if (ph == 0) { ph_prologue(C); return; }
    int layer, st;
    if (ph < 10) { layer = 0; st = ph - 1; } else if (ph < 22) { layer = 1; st = ph - 10; } else if (ph < 30) { layer = 2; st = ph - 22; } else { layer = 3; st = ph - 30; }
    const int mixer = layer % 3, j = layer / 3;
    unsigned char* big = C.ws + WS_BIG; const bf16_t* xn1 = (const bf16_t*)(C.ws + WS_XN1); const u64* ss_in = ss_arr(C, SS_IN + layer);
    if (mixer == 0) {
        if (st == 0) run_gemm(C, xn1, 1024, (const bf16_t*)(C.ws + WS_WMIX), 1024, 768, 1024,
                              pg8::EpiMlaA{ss_in, (bf16_t*)(big + BIG_ARAW), ss_arr(C, SS_Q + j), ss_arr(C, SS_KV + j), (bf16_t*)(C.ws + WS_KR), (const float*)(C.ws + WS_ROPE)});
        else if (st == 1) {
            run_gemm(C, (const bf16_t*)(big + BIG_ARAW), 768, (const bf16_t*)(C.ws + WS_WMIX + 2 * MiB), 384, 1536, 384, pg8::EpiMlaQ{ss_arr(C, SS_Q + j), (bf16_t*)(big + BIG_Q), (const float*)(C.ws + WS_ROPE)});
            const Ctx C2 = make_ctx(C.lds);
            run_gemm(C2, (const bf16_t*)(C2.ws + WS_BIG + BIG_ARAW) + 384, 768, (const bf16_t*)(C2.ws + WS_WMIX + 4 * MiB), 256, 2048, 256, pg8::EpiMlaKV{ss_arr(C2, SS_KV + j), (bf16_t*)(C2.ws + WS_BIG + BIG_KN), (bf16_t*)(C2.ws + WS_BIG + BIG_V)});
        } else if (st == 2) ph_attn_causal<96, att::MODE_CAUSAL>(C);
        else ph_common(C, layer, st - 3);
    } else if (mixer == 1) {
        if (st < 6) { const int g = st >> 1;
            if ((st & 1) == 0) { bf16_t* qkv = (bf16_t*)(big + BIG_QKVG);
                run_gemm(C, xn1, 1024, (const bf16_t*)(C.ws + WS_WMIX) + (size_t)g * 3072 * 1024, 1024, 3072, 1024, pg8::EpiQKV{ss_in, qkv, (size_t)1024, 3072, nullptr, nullptr});
            } else ph_attn_dil(C, g);
        } else ph_common(C, layer, st - 6);
    } else {
        if (st == 0) run_gemm(C, xn1, 1024, (const bf16_t*)(C.ws + WS_WMIX), 1024, 3328, 1024,
                              pg8::EpiQKV{ss_in, (bf16_t*)(big + BIG_FQ), (size_t)(BIG_FK - BIG_FQ) / 2, 1024, (float*)(C.ws + WS_LF), INP(C, 18) + j * 16});
        else if (st == 1) ph_attn_causal<64, att::MODE_FOX>(C);
        else ph_common(C, layer, st - 2);
    }
}


#ifdef DUP_MASK
__device__ __forceinline__ void ph_decode(int ph, int& layer, int& st) { if (ph < 10) { layer = 0; st = ph - 1; } else if (ph < 22) { layer = 1; st = ph - 10; } else if (ph < 30) { layer = 2; st = ph - 22; } else { layer = 3; st = ph - 30; } }
__device__ __forceinline__ int ph_class(int ph) {
    if (ph == 0) return 64;
    int layer, st; ph_decode(ph, layer, st); const int mixer = layer % 3; int cst;
    if (mixer == 0) { if (st == 1) return 4; if (st == 2) return 1; if (st < 3) return 0; cst = st - 3; }
    else if (mixer == 1) { if (st < 6) { if ((st & 1) == 0) return 4; return st == 1 ? 2 : 0; } cst = st - 6; }
    else { if (st == 0) return 4; if (st == 1) return 1; cst = st - 2; }
    return cst == 0 ? 8 : cst == 1 ? 32 : cst == 2 ? 16 : cst == 3 ? 8 : cst == 4 ? 32 : 0;
}
__device__ __forceinline__ bool dup_wanted(int ph) { return (ph_class(ph) & (DUP_MASK)) != 0; }
__device__ __forceinline__ void run_dup(const Ctx& C, int ph) {
    const int cls = ph_class(ph);
    if (cls == 8 || cls == 32) { int layer, st; ph_decode(ph, layer, st); const int mixer = layer % 3; const int cst = st - (mixer == 0 ? 3 : mixer == 1 ? 6 : 2); unsigned char* big = C.ws + WS_BIG;
        if (cst == 0) run_gemm(C, (const bf16_t*)(big + BIG_O), 1024, (const bf16_t*)(C.ws + WS_WO), 1024, 1024, 1024, pg8::EpiY<false>{(bf16_t*)(big + BIG_Y), nullptr});
        else if (cst == 3) run_gemm(C, (const bf16_t*)(big + BIG_ACT), DFF, (const bf16_t*)(C.ws + WS_WOUT), DFF, 1024, DFF, pg8::EpiY<false>{(bf16_t*)(big + BIG_Y2), nullptr});
        else if (cst == 1) ph_r1(C, layer, 0.0f); else ph_r2(C, layer, 0.0f);
    } else run_phase(C, ph);
}
#endif

#define XB_TMO      128
#define XB_XCNT(j)  (256  + 64 * (j))
#define XB_XSUB(j)  (1280 + 64 * (j))
#define XB_XGEN(j)  (2304 + 64 * (j))
#define XB_TOP      3328
#define XB_TOPGEN   3392
#define XCD_BAR_WORDS 3456
#define XB_SPIN_CAP (1u << 22)
__device__ __forceinline__ unsigned xb_ld(unsigned* p)              { return __hip_atomic_load(p, __ATOMIC_RELAXED, __HIP_MEMORY_SCOPE_AGENT); }
__device__ __forceinline__ unsigned xb_add(unsigned* p, unsigned v) { return __hip_atomic_fetch_add(p, v, __ATOMIC_RELAXED, __HIP_MEMORY_SCOPE_AGENT); }
__device__ __forceinline__ unsigned xb_xcc_id() { return (unsigned)__builtin_amdgcn_s_getreg((3 << 11) | 20) & 0xFu; }
#define XB_SPIN(cond, bar) do { unsigned _sp = 0; while (cond) { __builtin_amdgcn_s_sleep(1); \
    if ((++_sp & 255u) == 0u) { if (xb_ld(&(bar)[XB_TMO])) break; if (_sp > XB_SPIN_CAP) { atomicAdd(&(bar)[XB_TMO], 1u); break; } } } } while (0)
struct XcdBarrier { unsigned* bar; unsigned x; volatile LAS unsigned* st; };
__device__ __forceinline__ XcdBarrier xcd_barrier_post(unsigned* bar, volatile LAS unsigned* st) {
    XcdBarrier b; b.bar = bar; b.x = xb_xcc_id(); b.st = st;
    if (threadIdx.x == 0) (void)xb_add(&bar[XB_XCNT(b.x)], 1u);
    return b;
}
__device__ __forceinline__ void xcd_barrier_complete(unsigned* bar, unsigned x, unsigned& nloc, unsigned& nx) {
    const unsigned G = gridDim.x * gridDim.y * gridDim.z;
    unsigned sum, cnt, mine, sp = 0u;
    for (;;) {
        sum = 0u; cnt = 0u; mine = 0u;
#pragma unroll
        for (unsigned j = 0; j < 16; ++j) { const unsigned c = xb_ld(&bar[XB_XCNT(j)]); sum += c; cnt += (c > 0u) ? 1u : 0u; mine = (j == x) ? c : mine; }
        if (sum == G) break;
        __builtin_amdgcn_s_sleep(1);
        if ((++sp & 255u) == 0u) { if (xb_ld(&bar[XB_TMO])) break; if (sp > XB_SPIN_CAP) { atomicAdd(&bar[XB_TMO], 1u); break; } }
    }
    nloc = mine > 0u ? mine : 1u; nx = cnt > 0u ? cnt : 1u;
}
__device__ __forceinline__ void xcd_barrier(const XcdBarrier& b) {
    asm volatile("s_waitcnt vmcnt(0)" ::: "memory");
    __syncthreads();
    if (threadIdx.x == 0) {
        unsigned* bar = b.bar;
        __builtin_amdgcn_s_waitcnt(0);
        unsigned nloc = b.st[0], nx = b.st[1];
        if (nloc == 0u) { xcd_barrier_complete(bar, b.x, nloc, nx); b.st[0] = nloc; b.st[1] = nx; }
        const unsigned old = xb_add(&bar[XB_XSUB(b.x)], 1u);
        const unsigned gen = old / nloc;
        if (old + 1u == (gen + 1u) * nloc) {
            __builtin_amdgcn_fence(__ATOMIC_RELEASE, "agent");
            asm volatile("s_waitcnt vmcnt(0)" ::: "memory");
            const unsigned og = xb_add(&bar[XB_TOP], 1u);
            const unsigned tg = og / nx;
            if (og + 1u == (tg + 1u) * nx) xb_add(&bar[XB_TOPGEN], 1u);
            else XB_SPIN(xb_ld(&bar[XB_TOPGEN]) == tg, bar);
            __builtin_amdgcn_fence(__ATOMIC_ACQUIRE, "agent");
            xb_add(&bar[XB_XGEN(b.x)], 1u);
            asm volatile("s_waitcnt vmcnt(0)" ::: "memory");
        } else {
            XB_SPIN(xb_ld(&bar[XB_XGEN(b.x)]) == gen, bar);
            __builtin_amdgcn_fence(__ATOMIC_ACQUIRE, "agent");
            asm volatile("s_waitcnt vmcnt(0)" ::: "memory");
        }
    }
    __syncthreads();
}

__global__ void __launch_bounds__(NTHREADS, 2) mega_fwd(Args args) {
    extern __shared__ __attribute__((aligned(16))) unsigned char lds_raw[];
    volatile LAS unsigned* misc = (volatile LAS unsigned*)((LAS unsigned char*)lds_raw + RING_BYTES);
    if (threadIdx.x < 64) misc[threadIdx.x] = 0u;
    __syncthreads();
    XcdBarrier bar; bar.bar = (unsigned*)(args.ws + WS_CTL) + 64; bar.x = 0; bar.st = misc + 8;
    if (args.ph_hi - args.ph_lo > 1) bar = xcd_barrier_post((unsigned*)(args.ws + WS_CTL) + 64, misc + 8);
    for (int ph = args.ph_lo; ph < args.ph_hi; ++ph) {
        { const Ctx C = make_ctx((LAS unsigned char*)lds_raw); run_phase(C, ph); }
#ifdef DUP_MASK
        if (dup_wanted(ph)) { xcd_barrier(bar); const Ctx C = make_ctx((LAS unsigned char*)lds_raw); run_dup(C, ph); }
#endif
        if (ph + 1 < args.ph_hi) { if (ph == args.ph_lo) cg::this_grid().sync(); else xcd_barrier(bar); }
    }
}
#ifndef MK_MODE
#define MK_MODE 0
#endif
#if MK_MODE == 2
__global__ void dbg_compare(const float* a, const float* ref, int n, unsigned* flag, int stage, float tol2) {
    __shared__ float s1[1024], s2[1024];
    float e = 0.f, r = 0.f; bool bad = false;
    for (int i = threadIdx.x; i < n; i += 1024) { const float d = a[i] - ref[i]; e += d * d; r += ref[i] * ref[i]; if (!(fabsf(a[i]) < 1e30f)) bad = true; }
    s1[threadIdx.x] = bad ? 1e30f : e; s2[threadIdx.x] = r; __syncthreads();
    for (int o = 512; o > 0; o >>= 1) { if ((int)threadIdx.x < o) { s1[threadIdx.x] += s1[threadIdx.x + o]; s2[threadIdx.x] += s2[threadIdx.x + o]; } __syncthreads(); }
    if (threadIdx.x == 0) { if (!(s1[0] <= tol2 * s2[0])) atomicMin(flag, (unsigned)stage); }
}
__global__ void dbg_final(float* out, int n, const unsigned* flag) {
    const unsigned f = *flag; if (f == 0xffffffffu) return;
    for (int i = blockIdx.x * blockDim.x + threadIdx.x; i < n; i += gridDim.x * blockDim.x) out[i] = (i == 0) ? 1000.0f * (float)(f + 1) : 0.f;
}
#endif
extern "C" void kernel_launch(void* const* d_in, const int* in_sizes, int n_in, void* d_out, int out_size, void* d_ws, size_t ws_size, hipStream_t stream) {
    static int grid = 0;
    if (grid == 0) {
        int dev = 0, cus = 0, per_cu = 0;
        if (n_in != 20 || out_size != MTOK * DMODEL || ws_size < WS_END + (MK_MODE == 2 ? 64 * MiB : 0)) { fprintf(stderr, "kernel_launch: unexpected problem geometry (n_in %d out %d ws %zu)\n", n_in, out_size, ws_size); grid = -1; return; }
        (void)hipGetDevice(&dev); (void)hipDeviceGetAttribute(&cus, hipDeviceAttributeMultiprocessorCount, dev);
        if (hipFuncSetAttribute((const void*)mega_fwd, hipFuncAttributeMaxDynamicSharedMemorySize, LDS_BYTES) != hipSuccess) { fprintf(stderr, "kernel_launch: hipFuncSetAttribute failed\n"); grid = -1; return; }
        if (hipOccupancyMaxActiveBlocksPerMultiprocessor(&per_cu, (const void*)mega_fwd, NTHREADS, LDS_BYTES) != hipSuccess || per_cu < 1) { fprintf(stderr, "kernel_launch: occupancy query says %d blocks per CU\n", per_cu); grid = -1; (void)hipGetLastError(); return; }
        grid = cus;
        if (grid != 256) { fprintf(stderr, "kernel_launch: built for a 256-CU device, found %d CUs\n", cus); grid = -1; return; }
    }
    if (grid < 0) return;
    Args a{};
    for (int i = 0; i < 20; ++i) a.in[i] = (const float*)d_in[i];
    a.out = (float*)d_out; a.ws = (unsigned char*)d_ws;
#if MK_MODE == 0
    a.ph_lo = 0; a.ph_hi = N_PHASES;
    (void)hipMemsetAsync((char*)d_ws + WS_CTL, 0, 65536, stream);
    void* kargs[] = {&a};
    hipError_t e = hipLaunchCooperativeKernel((const void*)mega_fwd, dim3(grid), dim3(NTHREADS), kargs, LDS_BYTES, stream);
    if (e != hipSuccess) fprintf(stderr, "kernel_launch: cooperative launch failed: %s\n", hipGetErrorString(e));
#else
#if MK_MODE == 2
    unsigned char* ws = (unsigned char*)d_ws;
    float* ck = (float*)(ws + WS_END);
    unsigned* flag = (unsigned*)(ws + WS_CTL);
    (void)hipMemsetAsync(flag, 0xff, 4, stream);
    const size_t CKB = (size_t)SEQL * DMODEL * 4;
#endif
#ifndef PH_LIMIT
#define PH_LIMIT N_PHASES
#endif
    for (int ph = 0; ph < PH_LIMIT; ++ph) {
        a.ph_lo = ph; a.ph_hi = ph + 1;
        hipLaunchKernelGGL(mega_fwd, dim3(grid), dim3(NTHREADS), LDS_BYTES, stream, a);
#if MK_MODE == 2
        int k = -1;
        if (ph == 5) k = 0; else if (ph == 9) k = 1; else if (ph == 17) k = 2; else if (ph == 21) k = 3; else if (ph == 25) k = 4; else if (ph == 29) k = 5; else if (ph == 34) k = 6; else if (ph == 38) k = 7;
        if (k >= 0) (void)hipMemcpyAsync((char*)ck + k * CKB, d_out, CKB, hipMemcpyDeviceToDevice, stream);
#endif
    }
#if MK_MODE == 2
    nv::In I;
    I.x = (const float*)d_in[0]; I.p = (const float*)d_in[1]; I.pos = (const int*)d_in[2]; I.norm_g = (const float*)d_in[3];
    I.ffn_in = (const float*)d_in[4]; I.ffn_out = (const float*)d_in[5]; I.ple_proj = (const float*)d_in[6]; I.ple_gate = (const float*)d_in[7];
    I.rel_bias = (const float*)d_in[8]; I.mla_a = (const float*)d_in[9]; I.mla_qn = (const float*)d_in[10]; I.mla_kvn = (const float*)d_in[11];
    I.mla_uq = (const float*)d_in[12]; I.mla_ukv = (const float*)d_in[13]; I.mla_o = (const float*)d_in[14]; I.dil_qkv = (const float*)d_in[15];
    I.dil_o = (const float*)d_in[16]; I.fox_qkvf = (const float*)d_in[17]; I.fox_bf = (const float*)d_in[18]; I.fox_o = (const float*)d_in[19];
    float* nvh = (float*)(ws + WS_XN0);
    float* scr = (float*)(ws + WS_BIG);
    for (int i = 0; i < 4; ++i) {
        (void)hipMemcpyAsync(nvh, i == 0 ? (const void*)I.x : (const void*)((char*)ck + (2 * (i - 1) + 1) * CKB), CKB, hipMemcpyDeviceToDevice, stream);
        nv::dbg_mid = (float*)((char*)ck + (2 * i) * CKB); nv::dbg_flag = flag; nv::dbg_stage = 2 * i;
        nv::run_batch(stream, I, 0, nvh, scr, i, i + 1);
        hipLaunchKernelGGL(dbg_compare, dim3(1), dim3(1024), 0, stream, (const float*)((char*)ck + (2 * i + 1) * CKB), (const float*)nvh, SEQL * DMODEL, flag, 2 * i + 1, DBG_TOL2);
    }
    hipLaunchKernelGGL(dbg_final, dim3(1024), dim3(256), 0, stream, (float*)d_out, MTOK * DMODEL, (const unsigned*)flag);
#endif
#endif
}
```
